# Optimizing an MI355X kernel written in HIP

```python
import jax, jax.numpy as jnp
from jax import lax
import numpy as np

D_MODEL = 1024
BATCH = 16
SEQ = 2048
DEPTH = 2

CHUNK = 64
Q_BLOCK = 128
N_MIXERS = 2
EPS = 1e-6
NEG_INF = -1e30

N_MEM = 256
MEM_HEADS = 4
MEM_HEAD_DIM = 64
MEM_WIDTH = MEM_HEADS * MEM_HEAD_DIM

POOL_WINDOWS = (2, 4, 8, 16)
POOL_GROUPS = len(POOL_WINDOWS)
POOL_GROUP_DIM = 192
POOL_WIDTH = POOL_GROUPS * POOL_GROUP_DIM

MLA_HEADS = 6
QK_NOPE = 128
QK_ROPE = 64
V_HEAD = 128
Q_LORA = 384
KV_LORA = 256
MLA_WIDTH = MLA_HEADS * V_HEAD
ROPE_THETA = 10000.0

MIX_WIDTH = POOL_WIDTH + MEM_WIDTH
POOL_IN = POOL_WIDTH + MEM_WIDTH + MIX_WIDTH
MLA_IN = Q_LORA + KV_LORA + QK_ROPE + MEM_WIDTH + MIX_WIDTH

N_POOL_LAYERS = (DEPTH + N_MIXERS - 1) // N_MIXERS
N_MLA_LAYERS = DEPTH // N_MIXERS

kernel_name = "hybrid_pool_mla_memory_trunk"


def rms_norm(x, g):
    x32 = x.astype(jnp.float32)
    y = x32 * lax.rsqrt(jnp.mean(x32 * x32, axis=-1, keepdims=True) + EPS)
    return (y * g.astype(jnp.float32)).astype(x.dtype)


def rope_tables(positions):
    inv_freq = ROPE_THETA ** (-(jnp.arange(0, QK_ROPE, 2, dtype=jnp.float32) / QK_ROPE))
    ang = positions.astype(jnp.float32)[..., None] * inv_freq
    return jnp.cos(ang), jnp.sin(ang)


def apply_rope(x, cos, sin):
    x32 = x.astype(jnp.float32)
    x1, x2 = jnp.split(x32, 2, axis=-1)
    out = jnp.concatenate([x1 * cos - x2 * sin, x2 * cos + x1 * sin], axis=-1)
    return out.astype(x.dtype)


def multi_scale_pool(u, w_group, scale):
    b, s, _ = u.shape
    u32 = u.astype(jnp.float32).reshape(b, s, POOL_GROUPS, POOL_GROUP_DIM)
    csum = jnp.cumsum(u32, axis=1)
    t = jnp.arange(s)
    pooled = []
    for gi, w in enumerate(POOL_WINDOWS):
        c = csum[:, :, gi]
        prev = jnp.pad(c, ((0, 0), (w, 0), (0, 0)))[:, :s]
        cnt = jnp.minimum(t + 1, w).astype(jnp.float32)
        pooled.append((c - prev) / cnt[None, :, None])
    mixed = jnp.stack(pooled, axis=2) - u32
    y = jnp.einsum('bsgc,gcd->bsgd', mixed.astype(u.dtype), w_group)
    return y.reshape(b, s, POOL_WIDTH) * scale


def memory_attention(q, mem_k, mem_v):
    b, s = q.shape[:2]
    sc = jnp.einsum('bqhd,bkhd->bhqk', q, mem_k).astype(jnp.float32) * (MEM_HEAD_DIM ** -0.5)
    p = jax.nn.softmax(sc, axis=-1).astype(mem_v.dtype)
    o = jnp.einsum('bhqk,bkhd->bqhd', p, mem_v)
    return o.reshape(b, s, MEM_WIDTH)


def mla_attention(q_nope, q_rope, k_nope, k_rope, v):
    s = q_nope.shape[1]
    scale = (QK_NOPE + QK_ROPE) ** -0.5
    outs = []
    for blk in range(s // Q_BLOCK):
        q0, q1 = blk * Q_BLOCK, (blk + 1) * Q_BLOCK
        kv_end = q1
        sc = (jnp.einsum('bqhd,bkhd->bhqk', q_nope[:, q0:q1], k_nope[:, :kv_end])
              + jnp.einsum('bqhd,bkd->bhqk', q_rope[:, q0:q1], k_rope[:, :kv_end]))
        q_chunk = (q0 + jnp.arange(Q_BLOCK)) // CHUNK
        k_chunk = jnp.arange(kv_end) // CHUNK
        mask = k_chunk[None, :] <= q_chunk[:, None]
        sc = jnp.where(mask, sc.astype(jnp.float32) * scale, NEG_INF)
        p = jax.nn.softmax(sc, axis=-1).astype(v.dtype)
        outs.append(jnp.einsum('bhqk,bkhd->bqhd', p, v[:, :kv_end]))
    return jnp.concatenate(outs, axis=1)


def setup_inputs(seed: int = 0) -> dict:
    key = jax.random.key(seed)
    ks = jax.random.split(key, 20)
    f32 = jnp.float32

    def nrm(k, shape, fan_in):
        return jax.random.normal(k, shape, f32) * (fan_in ** -0.5)

    def gain(k, shape):
        return 1.0 + 0.02 * jax.random.normal(k, shape, f32)

    x = jax.random.normal(ks[0], (BATCH, SEQ, D_MODEL), f32)
    mem = jax.random.normal(ks[1], (BATCH, N_MEM, D_MODEL), f32)
    start = jax.random.randint(ks[2], (BATCH, 1), 0, 4096, dtype=jnp.int32)
    positions = (start + jnp.arange(SEQ, dtype=jnp.int32)[None, :]).astype(jnp.int32)
    return {
        "x": x,
        "mem": mem,
        "positions": positions,
        "norm_g": gain(ks[3], (DEPTH, D_MODEL)),
        "mem_norm_g": gain(ks[4], (D_MODEL,)),
        "w_mem_kv": nrm(ks[5], (DEPTH, D_MODEL, 2 * MEM_WIDTH), D_MODEL),
        "w_out": nrm(ks[6], (DEPTH, MIX_WIDTH, D_MODEL), MIX_WIDTH),
        "pool_w_in": nrm(ks[7], (N_POOL_LAYERS, D_MODEL, POOL_IN), D_MODEL),
        "pool_w_group": nrm(ks[8], (N_POOL_LAYERS, POOL_GROUPS, POOL_GROUP_DIM, POOL_GROUP_DIM), POOL_GROUP_DIM),
        "pool_scale": gain(ks[9], (N_POOL_LAYERS, POOL_WIDTH)),
        "mla_w_in": nrm(ks[10], (N_MLA_LAYERS, D_MODEL, MLA_IN), D_MODEL),
        "mla_q_norm_g": gain(ks[11], (N_MLA_LAYERS, Q_LORA)),
        "mla_w_uq": nrm(ks[12], (N_MLA_LAYERS, Q_LORA, MLA_HEADS * (QK_NOPE + QK_ROPE)), Q_LORA),
        "mla_kv_norm_g": gain(ks[13], (N_MLA_LAYERS, KV_LORA)),
        "mla_w_ukv": nrm(ks[14], (N_MLA_LAYERS, KV_LORA, MLA_HEADS * (QK_NOPE + V_HEAD)), KV_LORA),
        "final_norm_g": gain(ks[15], (D_MODEL,)),
    }


def reference(x, mem, positions, norm_g, mem_norm_g, w_mem_kv, w_out, pool_w_in, pool_w_group,
              pool_scale, mla_w_in, mla_q_norm_g, mla_w_uq, mla_kv_norm_g, mla_w_ukv, final_norm_g):
    b, s, _ = x.shape
    cos, sin = rope_tables(positions)
    mem_n = rms_norm(mem, mem_norm_g)
    h = x
    for i in range(DEPTH):
        j = i // N_MIXERS
        hn = rms_norm(h, norm_g[i])
        mem_kv = jnp.einsum('bnd,de->bne', mem_n, w_mem_kv[i])
        mem_k, mem_v = jnp.split(mem_kv.reshape(b, N_MEM, 2, MEM_HEADS, MEM_HEAD_DIM), 2, axis=2)
        mem_k, mem_v = mem_k[:, :, 0], mem_v[:, :, 0]
        if i % N_MIXERS == 0:
            proj = jnp.einsum('bsd,de->bse', hn, pool_w_in[j])
            u, mq, gate = jnp.split(proj, [POOL_WIDTH, POOL_WIDTH + MEM_WIDTH], axis=-1)
            tok = multi_scale_pool(u, pool_w_group[j], pool_scale[j])
        else:
            proj = jnp.einsum('bsd,de->bse', hn, mla_w_in[j])
            c_q, c_kv, k_rope, mq, gate = jnp.split(
                proj, [Q_LORA, Q_LORA + KV_LORA, Q_LORA + KV_LORA + QK_ROPE,
                       Q_LORA + KV_LORA + QK_ROPE + MEM_WIDTH], axis=-1)
            q = jnp.einsum('bsr,re->bse', rms_norm(c_q, mla_q_norm_g[j]), mla_w_uq[j])
            q = q.reshape(b, s, MLA_HEADS, QK_NOPE + QK_ROPE)
            q_nope, q_rope = q[..., :QK_NOPE], q[..., QK_NOPE:]
            q_rope = apply_rope(q_rope, cos[:, :, None, :], sin[:, :, None, :])
            kv = jnp.einsum('bsr,re->bse', rms_norm(c_kv, mla_kv_norm_g[j]), mla_w_ukv[j])
            kv = kv.reshape(b, s, MLA_HEADS, QK_NOPE + V_HEAD)
            k_nope, v = kv[..., :QK_NOPE], kv[..., QK_NOPE:]
            k_rope = apply_rope(k_rope, cos, sin)
            tok = mla_attention(q_nope, q_rope, k_nope, k_rope, v).reshape(b, s, MLA_WIDTH)
        mem_o = memory_attention(mq.reshape(b, s, MEM_HEADS, MEM_HEAD_DIM), mem_k, mem_v)
        branch = jnp.concatenate([tok.astype(h.dtype), mem_o], axis=-1) * jax.nn.silu(gate)
        h = h + jnp.einsum('bse,ed->bsd', branch, w_out[i])
    return rms_norm(h, final_norm_g)
```

```cpp
#include <hip/hip_runtime.h>
#include <cstdio>
#include <cstdint>

#ifndef MK_N_LAUNCHES
#define MK_N_LAUNCHES 1
#endif

#define LAS __attribute__((address_space(3)))
#define GAS __attribute__((address_space(1)))
typedef unsigned short bf16_t;
typedef short bf16x8 __attribute__((ext_vector_type(8)));
typedef float f32x4 __attribute__((ext_vector_type(4)));
typedef float f32x2 __attribute__((ext_vector_type(2)));
typedef unsigned u32x4 __attribute__((ext_vector_type(4)));
typedef unsigned u32x2 __attribute__((ext_vector_type(2)));
typedef GAS unsigned gu32;

constexpr int BATCH = 16, SEQ = 2048, DM = 1024, M = BATCH * SEQ;
constexpr int NMEM = 256, MROWS = BATCH * NMEM;
constexpr int PLD = 2048;
constexpr int L0_MQ = 768, L0_GATE = 1024;
constexpr int L1_CKV = 384, L1_KR = 640, L1_MQ = 704, L1_GATE = 960, L1_END = 1984;
constexpr int QLD = 1152, KLD = 768;
constexpr float EPS = 1e-6f, LOG2E = 1.4426950408889634f;
constexpr float MQ_C2 = 0.125f * LOG2E;
constexpr float Q_C2 = 0.07216878364870323f * LOG2E;

constexpr size_t MiB = 1u << 20;
constexpr size_t WS_CTL = 0, CTL_ZERO_BYTES = 2 * MiB;
constexpr size_t WS_SSQ = 1 * MiB;
constexpr size_t WS_WIN0 = 2 * MiB, WS_WMKV = 6 * MiB, WS_WOUT0 = 8 * MiB, WS_WOUT1 = 10 * MiB, WS_WIN1 = 12 * MiB, WS_WUQ = 16 * MiB, WS_WUKV = 17 * MiB;
constexpr size_t WS_CS = 18 * MiB, WS_MN = 26 * MiB, WS_MEMKV = 34 * MiB;
constexpr size_t WS_XN = 48 * MiB;
constexpr size_t WS_PROJ = 112 * MiB, WS_BR = 240 * MiB, WS_Q = 304 * MiB, WS_KN = 376 * MiB, WS_VV = 424 * MiB, WS_END = 472 * MiB;
constexpr int CW_BAR = 4096;

namespace pg8 {
constexpr int BM = 256, BK = 64, HALF = 128, HTB = HALF * BK * 2, STAGE_BYTES = 8 * HTB, NXCD = 8, WGM = 8;
__host__ __device__ __forceinline__ int lds_byte(int r, int c) { const int st = (r >> 4) * 2 + (c >> 5), rr = r & 15, cc = c & 31, ob = rr * 64 + cc * 2; return st * 1024 + (ob ^ (((ob >> 9) & 1) << 5)); }
__host__ __device__ __forceinline__ void stage_rc(int b, int& R, int& C) { const int st = b / 1024, sb = b % 1024, swz = sb ^ (((sb >> 9) & 1) << 5); R = (st >> 1) * 16 + swz / 64; C = (st & 1) * 32 + (swz % 64) / 2; }
__host__ __device__ __forceinline__ int perm32(int rho) { const int n = rho >> 4, i = rho & 15; return 8 * (i >> 2) + 4 * n + (i & 3); }

struct Unit { int pm, pn, g; };
__device__ __forceinline__ int static_unit(int M_, int N_, int L) {
    const int nM = M_ / BM, nN = N_ / BM, nwg = nM * nN;
    int wgid = L; { const int q = nwg / NXCD, r = nwg % NXCD, xcd = wgid % NXCD, off = wgid / NXCD; wgid = (xcd < r ? xcd * (q + 1) : r * (q + 1) + (xcd - r) * q) + off; }
    const int nig = WGM * nN, gid = wgid / nig, fm = gid * WGM, gsz = (nM - fm) < WGM ? (nM - fm) : WGM;
    return ((fm + ((wgid % nig) % gsz)) << 16) | ((wgid % nig) / gsz);
}
struct Sched1 {
    const bf16_t* A; const bf16_t* Bt; int M_, N_, lda, ldb, G, c;
    __device__ __forceinline__ Unit next(int i, bool& ok) const { const int L = i * G + c; ok = L < (M_ / BM) * (N_ / BM); const int p = static_unit(M_, N_, ok ? L : 0); return Unit{p >> 16, p & 0xffff, 0}; }
    __device__ __forceinline__ const char* aptr(const Unit& u) const { return (const char*)(A + (size_t)u.pm * BM * lda); }
    __device__ __forceinline__ const char* bptr(const Unit& u) const { return (const char*)(Bt + (size_t)u.pn * BM * ldb); }
};
struct Sched2 {
    const bf16_t* A0; const bf16_t* B0; const bf16_t* A1; const bf16_t* B1; int M0, N0, M1, N1, lda, ldb, G, c;
    __device__ __forceinline__ Unit next(int i, bool& ok) const {
        const int n0 = (M0 / BM) * (N0 / BM), n1 = (M1 / BM) * (N1 / BM), L = i * G + c; ok = L < n0 + n1;
        const int p = static_unit(M0, N0, L < n0 ? L : 0), r = L - n0, g = L >= n0 ? 1 : 0;
        return Unit{g ? r / (N1 / BM) : (p >> 16), g ? r % (N1 / BM) : (p & 0xffff), g};
    }
    __device__ __forceinline__ const char* aptr(const Unit& u) const { return (const char*)((u.g ? A1 : A0) + (size_t)u.pm * BM * lda); }
    __device__ __forceinline__ const char* bptr(const Unit& u) const { return (const char*)((u.g ? B1 : B0) + (size_t)u.pn * BM * ldb); }
};

template <class Epi, class Sched>
__device__ __forceinline__ void gemm_phase(LAS unsigned char* lds, const int K, const int lda, const int ldb, const Sched& S, const Epi& E) {
    const int tid = threadIdx.x, wid = __builtin_amdgcn_readfirstlane(tid >> 6), lane = tid & 63, wr = wid >> 2, wc = wid & 3, fr = lane & 15, fq = lane >> 4;
    const int nt = K / BK;
    unsigned voffA[2], voffB[2];
#pragma unroll
    for (int i = 0; i < 2; ++i) { int R, C; stage_rc(tid * 16 + i * 8192, R, C); const int Rb = Epi::PERM ? ((R & ~31) + perm32(R & 31)) : R;
        voffA[i] = (unsigned)(R * lda + C) * 2u; voffB[i] = (unsigned)(Rb * ldb + C) * 2u; }
    const size_t kstep = (size_t)(BK * 2);
    const size_t hstepA = (size_t)HALF * lda * 2, hstepB = (size_t)HALF * ldb * 2;
    const unsigned ldsw = (unsigned)wid * 1024u;
    const int aoff = lds_byte(wr * 64 + fr, fq * 8), boff = lds_byte(wc * 32 + fr, fq * 8);
#define PG8_SA(b, h) (((b) * 2 + (h)) * HTB)
#define PG8_SB(b, h) ((4 + (b) * 2 + (h)) * HTB)
#define PG8_STAGE(bufoff, gbase, voff) do { _Pragma("unroll") for (int _i = 0; _i < 2; ++_i) \
        __builtin_amdgcn_global_load_lds((const unsigned*)((const char*)(gbase) + (voff)[_i]), (LAS unsigned*)(lds + (bufoff) + ldsw + _i * 8192), 16, 0, 0); } while (0)
#define PG8_LDA(dst, b, h) do { _Pragma("unroll") for (int m = 0; m < 4; ++m) _Pragma("unroll") for (int k = 0; k < 2; ++k) dst[m][k] = *(const LAS bf16x8*)(lds + PG8_SA(b, h) + aoff + m * 2048 + k * 1024); } while (0)
#define PG8_LDB(dst, b, h) do { _Pragma("unroll") for (int n = 0; n < 2; ++n) _Pragma("unroll") for (int k = 0; k < 2; ++k) dst[n][k] = *(const LAS bf16x8*)(lds + PG8_SB(b, h) + boff + n * 2048 + k * 1024); } while (0)
#define PG8_MMA(ai, bj, At, Bt) do { __builtin_amdgcn_s_setprio(1); _Pragma("unroll") for (int m = 0; m < 4; ++m) _Pragma("unroll") for (int n = 0; n < 2; ++n) _Pragma("unroll") for (int k = 0; k < 2; ++k) \
        acc[ai][bj][m][n] = __builtin_amdgcn_mfma_f32_16x16x32_bf16(Bt[n][k], At[m][k], acc[ai][bj][m][n], 0, 0, 0); __builtin_amdgcn_s_setprio(0); } while (0)
#define PG8_WAIT_V(n) asm volatile("s_waitcnt vmcnt(" #n ")" ::: "memory")
#define PG8_WAIT_L(n) asm volatile("s_waitcnt lgkmcnt(" #n ")" ::: "memory")
#define PG8_BAR __builtin_amdgcn_s_barrier()
#define PG8_SCHED __builtin_amdgcn_sched_barrier(0)
    int ui = 0; bool ok0;
    Unit cur = S.next(0, ok0);
    if (!ok0) return;
    f32x4 acc[2][2][4][2];
#pragma unroll
    for (int a = 0; a < 2; ++a)
#pragma unroll
        for (int b = 0; b < 2; ++b)
#pragma unroll
            for (int m = 0; m < 4; ++m)
#pragma unroll
                for (int n = 0; n < 2; ++n) acc[a][b][m][n] = (f32x4){0.f, 0.f, 0.f, 0.f};
    bf16x8 At[4][2], B0[2][2], B1[2][2];
    const char* cA = S.aptr(cur); const char* cB = S.bptr(cur);
    PG8_STAGE(PG8_SB(0, 0), cB, voffB); PG8_STAGE(PG8_SB(0, 1), cB + hstepB, voffB); PG8_STAGE(PG8_SA(0, 0), cA, voffA); PG8_STAGE(PG8_SA(0, 1), cA + hstepA, voffA);
    if (wr == 1) PG8_BAR;
    PG8_WAIT_V(2); PG8_BAR;
    PG8_STAGE(PG8_SB(1, 0), cB + kstep, voffB); PG8_STAGE(PG8_SA(1, 0), cA + kstep, voffA); PG8_STAGE(PG8_SB(1, 1), cB + hstepB + kstep, voffB);
    PG8_WAIT_V(6); PG8_BAR;
    for (;;) {
        bool has_next; const Unit nxt = S.next(ui + 1, has_next);
        const char* nA = has_next ? S.aptr(nxt) : cA; const char* nB = has_next ? S.bptr(nxt) : cB;
#pragma unroll 1
        for (int t = 0; t < nt; t += 2) {
            const bool last = (t == nt - 2);
            const char* a1 = cA + (size_t)(t + 1) * kstep;
            const char* a2 = last ? nA : cA + (size_t)(t + 2) * kstep; const char* b2 = last ? nB : cB + (size_t)(t + 2) * kstep;
            const char* a3 = a2 + kstep; const char* b3 = b2 + kstep;
            PG8_LDB(B0, 0, 0); PG8_LDB(B1, 0, 1); PG8_SCHED; PG8_LDA(At, 0, 0); PG8_STAGE(PG8_SA(1, 1), a1 + hstepA, voffA);
            PG8_WAIT_V(8); PG8_WAIT_L(0); PG8_BAR; PG8_MMA(0, 0, At, B0); PG8_MMA(0, 1, At, B1); PG8_BAR; PG8_SCHED;
            PG8_LDA(At, 0, 1); PG8_STAGE(PG8_SB(0, 0), b2, voffB); PG8_STAGE(PG8_SB(0, 1), b2 + hstepB, voffB); PG8_STAGE(PG8_SA(0, 0), a2, voffA);
            PG8_WAIT_V(8); PG8_WAIT_L(0); PG8_BAR; PG8_MMA(1, 0, At, B0); PG8_MMA(1, 1, At, B1); PG8_BAR; PG8_SCHED;
            PG8_LDB(B0, 1, 0); PG8_LDB(B1, 1, 1); PG8_SCHED; PG8_LDA(At, 1, 0); PG8_STAGE(PG8_SA(0, 1), a2 + hstepA, voffA);
            PG8_WAIT_V(8); PG8_WAIT_L(0); PG8_BAR; PG8_MMA(0, 0, At, B0); PG8_MMA(0, 1, At, B1); PG8_BAR; PG8_SCHED;
            PG8_LDA(At, 1, 1); PG8_STAGE(PG8_SB(1, 0), b3, voffB); PG8_STAGE(PG8_SB(1, 1), b3 + hstepB, voffB); PG8_STAGE(PG8_SA(1, 0), a3, voffA);
            PG8_WAIT_V(8); PG8_WAIT_L(0); PG8_BAR; PG8_MMA(1, 0, At, B0); PG8_MMA(1, 1, At, B1); PG8_BAR; PG8_SCHED;
        }
        if (wr == 0) PG8_BAR;
        E(acc, cur, wr, wc, fr, fq);
        if (!has_next) break;
#pragma unroll
        for (int a = 0; a < 2; ++a)
#pragma unroll
            for (int b = 0; b < 2; ++b)
#pragma unroll
                for (int m = 0; m < 4; ++m)
#pragma unroll
                    for (int n = 0; n < 2; ++n) acc[a][b][m][n] = (f32x4){0.f, 0.f, 0.f, 0.f};
        cur = nxt; cA = nA; cB = nB; ++ui;
        if (wr == 1) PG8_BAR;
    }
    PG8_WAIT_V(0);
    PG8_BAR;
#undef PG8_SA
#undef PG8_SB
#undef PG8_STAGE
#undef PG8_LDA
#undef PG8_LDB
#undef PG8_MMA
#undef PG8_WAIT_V
#undef PG8_WAIT_L
#undef PG8_BAR
#undef PG8_SCHED
}
}

#define RLX_AGENT __ATOMIC_RELAXED, __HIP_MEMORY_SCOPE_AGENT
#define LDS_WAIT() asm volatile("s_waitcnt lgkmcnt(0)" ::: "memory")
#define VM_WAIT() asm volatile("s_waitcnt vmcnt(0)" ::: "memory")
__device__ __forceinline__ unsigned f2bf(float f) { unsigned u = __builtin_bit_cast(unsigned, f); return (u + 0x7fffu + ((u >> 16) & 1u)) >> 16; }
__device__ __forceinline__ unsigned pk2(float lo, float hi) { return f2bf(lo) | (f2bf(hi) << 16); }
__device__ __forceinline__ float bf2f(unsigned short b) { return __builtin_bit_cast(float, (unsigned)b << 16); }
__device__ __forceinline__ float bflo(unsigned w) { return __builtin_bit_cast(float, w << 16); }
__device__ __forceinline__ float bfhi(unsigned w) { return __builtin_bit_cast(float, w & 0xffff0000u); }
__device__ __forceinline__ unsigned cvt_pk_bf16(float lo, float hi) { unsigned r; asm volatile("v_cvt_pk_bf16_f32 %0, %1, %2" : "=v"(r) : "v"(lo), "v"(hi)); return r; }
__device__ __forceinline__ float silu_f(float x) { return x * __builtin_amdgcn_rcpf(1.0f + __builtin_amdgcn_exp2f(-x * LOG2E)); }
__device__ __forceinline__ float wave_sum(float v) {
#pragma unroll
    for (int o = 1; o < 64; o <<= 1) v += __shfl_xor(v, o);
    return v;
}
__device__ __forceinline__ float wave_max(float v) {
#pragma unroll
    for (int o = 1; o < 64; o <<= 1) v = fmaxf(v, __shfl_xor(v, o));
    return v;
}

#define XB_TMO      128
#define XB_XCNT(j)  (256  + 64 * (j))
#define XB_XSUB(j)  (1280 + 64 * (j))
#define XB_XGEN(j)  (2304 + 64 * (j))
#define XB_TOP      3328
#define XB_TOPGEN   3392
#define XCD_BAR_WORDS 3456
#define XB_SPIN_CAP (1u << 18)
__device__ __forceinline__ unsigned xb_ld(unsigned* p)              { return __hip_atomic_load(p, __ATOMIC_RELAXED, __HIP_MEMORY_SCOPE_AGENT); }
__device__ __forceinline__ unsigned xb_add(unsigned* p, unsigned v) { return __hip_atomic_fetch_add(p, v, __ATOMIC_RELAXED, __HIP_MEMORY_SCOPE_AGENT); }
__device__ __forceinline__ unsigned xb_xcc_id() { return (unsigned)__builtin_amdgcn_s_getreg((3 << 11) | 20) & 0xFu; }
#define XB_SPIN(cond, bar) do { unsigned _sp = 0; while (cond) { __builtin_amdgcn_s_sleep(1); \
    if ((++_sp & 255u) == 0u) { if (xb_ld(&(bar)[XB_TMO])) break; if (_sp > XB_SPIN_CAP) { atomicAdd(&(bar)[XB_TMO], 1u); break; } } } } while (0)
struct XcdBarrier { unsigned* bar; unsigned x; volatile LAS unsigned* st; };
__device__ __forceinline__ XcdBarrier xcd_barrier_post(unsigned* bar, volatile LAS unsigned* st) {
    XcdBarrier b; b.bar = bar; b.x = xb_xcc_id(); b.st = st;
    if (threadIdx.x == 0) (void)xb_add(&bar[XB_XCNT(b.x)], 1u);
    return b;
}
__device__ __forceinline__ void xcd_barrier_complete(unsigned* bar, unsigned x, unsigned& nloc, unsigned& nx) {
    const unsigned G = gridDim.x * gridDim.y * gridDim.z;
    unsigned sum, cnt, mine, sp = 0u;
    for (;;) {
        sum = 0u; cnt = 0u; mine = 0u;
#pragma unroll
        for (unsigned j = 0; j < 16; ++j) { const unsigned c = xb_ld(&bar[XB_XCNT(j)]); sum += c; cnt += (c > 0u) ? 1u : 0u; mine = (j == x) ? c : mine; }
        if (sum == G) break;
        __builtin_amdgcn_s_sleep(1);
        if ((++sp & 255u) == 0u) { if (xb_ld(&bar[XB_TMO])) break; if (sp > XB_SPIN_CAP) { atomicAdd(&bar[XB_TMO], 1u); break; } }
    }
    nloc = mine > 0u ? mine : 1u; nx = cnt > 0u ? cnt : 1u;
}
__device__ __forceinline__ void xcd_barrier(const XcdBarrier& b) {
    asm volatile("s_waitcnt vmcnt(0)" ::: "memory");
    __syncthreads();
    if (threadIdx.x == 0) {
        unsigned* bar = b.bar;
        __builtin_amdgcn_s_waitcnt(0);
        unsigned nloc = b.st[0], nx = b.st[1];
        if (nloc == 0u) { xcd_barrier_complete(bar, b.x, nloc, nx); b.st[0] = nloc; b.st[1] = nx; }
        const unsigned old = xb_add(&bar[XB_XSUB(b.x)], 1u);
        const unsigned gen = old / nloc;
        if (old + 1u == (gen + 1u) * nloc) {
            __builtin_amdgcn_fence(__ATOMIC_RELEASE, "agent");
            asm volatile("s_waitcnt vmcnt(0)" ::: "memory");
            const unsigned og = xb_add(&bar[XB_TOP], 1u);
            const unsigned tg = og / nx;
            if (og + 1u == (tg + 1u) * nx) xb_add(&bar[XB_TOPGEN], 1u);
            else XB_SPIN(xb_ld(&bar[XB_TOPGEN]) == tg, bar);
            __builtin_amdgcn_fence(__ATOMIC_ACQUIRE, "agent");
            xb_add(&bar[XB_XGEN(b.x)], 1u);
            asm volatile("s_waitcnt vmcnt(0)" ::: "memory");
        } else {
            XB_SPIN(xb_ld(&bar[XB_XGEN(b.x)]) == gen, bar);
            __builtin_amdgcn_fence(__ATOMIC_ACQUIRE, "agent");
            asm volatile("s_waitcnt vmcnt(0)" ::: "memory");
        }
    }
    __syncthreads();
}

constexpr int NWAVES = 8;
constexpr int RING_OFF = 0, RING_BYTES = 131072;
constexpr int LDSCTL_OFF = RING_BYTES, MISC_OFF = LDSCTL_OFF + 320;
constexpr int LDS_BYTES = 147456;

struct Frame {
    LAS unsigned char* lds;
    volatile LAS unsigned* MISC;
    gu32* ctl;
    int tid, lane, wave, vcu, G;
    const float *x, *mem, *norm_g, *mem_norm_g, *w_mem_kv, *w_out, *pool_w_in, *pool_w_group, *pool_scale, *mla_w_in, *mla_q_norm_g, *mla_w_uq, *mla_kv_norm_g, *mla_w_ukv, *final_norm_g;
    const int* positions;
    float* out;
    bf16_t *WIN0, *WMKV, *WOUT0, *WOUT1, *WIN1, *WUQ, *WUKV;
    bf16_t *XN, *MN, *MEMKV, *PROJ, *BR, *Q, *KN, *VV;
    float *CS, *ssq1, *ssq_q, *ssq_kv, *ssq2;
};

template <int MODE>
__device__ __forceinline__ int src_col(int n) {
    if (MODE == 1) { if (n >= L1_KR && n < L1_MQ) { const int j = n - L1_KR; return L1_KR + (j >> 1) + 32 * (j & 1); } return n; }
    if (MODE == 2) { const int h = n / 192, d = n - h * 192; if (d >= 128) { const int j = d - 128; return h * 192 + 128 + (j >> 1) + 32 * (j & 1); } return n; }
    return n;
}
__device__ __forceinline__ void transpose_writeout(LAS float* scr, bf16_t* WT, int K, int row0, int k0, int lane) {
    LDS_WAIT(); asm volatile("" ::: "memory");
    const int c = lane & 7;
#pragma unroll
    for (int j = 0; j < 4; ++j) { const int n = (lane >> 3) + 8 * j; const LAS float* s = scr + (8 * c) * 33 + n;
        u32x4 o; o.x = pk2(s[0 * 33], s[1 * 33]); o.y = pk2(s[2 * 33], s[3 * 33]); o.z = pk2(s[4 * 33], s[5 * 33]); o.w = pk2(s[6 * 33], s[7 * 33]);
        *(GAS u32x4*)(WT + (size_t)(row0 + n) * K + k0 + 8 * c) = o; }
    LDS_WAIT(); asm volatile("" ::: "memory");
}
template <int MODE>
__device__ __forceinline__ void p0_transpose_item(const float* W, int ldw, int col0, int nsrc, int K, int Ndst, const float* gain, bf16_t* WT, LAS float* scr, int item, int lane) {
    const int nblk = Ndst / 32, kb = item / nblk, nb = item % nblk, k0 = 64 * kb, n0 = 32 * nb;
    const int sc = src_col<MODE>(n0 + (lane & 31)); const bool ok = sc < nsrc;
#pragma unroll 8
    for (int i = 0; i < 32; ++i) { const int kk = 2 * i + (lane >> 5);
        float v = ok ? W[(size_t)(k0 + kk) * ldw + col0 + sc] : 0.f; if (gain) v *= gain[k0 + kk];
        scr[kk * 33 + (lane & 31)] = v; }
    transpose_writeout(scr, WT, K, n0, k0, lane);
}
__device__ __forceinline__ void p0_fold_item(const float* Win, const float* wg, const float* scale, bf16_t* WT, LAS float* scr, int item, int lane) {
    const int nblk = 768 / 32, kb = item / nblk, nb = item % nblk, k0 = 64 * kb, n0 = 32 * nb, g = n0 / 192, d = n0 - g * 192 + (lane & 31);
    const float* wgc = wg + (size_t)g * 192 * 192 + d;
    const float sc = scale[g * 192 + d];
    for (int ch = 0; ch < 3; ++ch) {
        float wv[64];
#pragma unroll
        for (int c = 0; c < 64; ++c) wv[c] = wgc[(size_t)(ch * 64 + c) * 192];
#pragma unroll 2
        for (int i = 0; i < 32; ++i) { const int kk = 2 * i + (lane >> 5);
            const f32x4* wr = (const f32x4*)(Win + (size_t)(k0 + kk) * 2048 + g * 192 + ch * 64);
            float a = 0.f;
#pragma unroll
            for (int c4 = 0; c4 < 16; ++c4) { const f32x4 w = wr[c4]; a += w.x * wv[4 * c4] + w.y * wv[4 * c4 + 1] + w.z * wv[4 * c4 + 2] + w.w * wv[4 * c4 + 3]; }
            LAS float* p = scr + kk * 33 + (lane & 31);
            if (ch == 0) *p = a; else if (ch == 1) *p += a; else *p = (*p + a) * sc; }
        LDS_WAIT(); asm volatile("" ::: "memory");
    }
    transpose_writeout(scr, WT, 1024, n0, k0, lane);
}
__device__ __forceinline__ void rms_row_to_bf16(const float* xrow, const float* g, bf16_t* orow, int lane) {
    const GAS f32x4* xr = (const GAS f32x4*)xrow + lane; const GAS f32x4* gr = (const GAS f32x4*)g + lane;
    f32x4 v[4]; float s = 0.f;
#pragma unroll
    for (int j = 0; j < 4; ++j) { v[j] = xr[64 * j]; s += (v[j].x * v[j].x + v[j].y * v[j].y) + (v[j].z * v[j].z + v[j].w * v[j].w); }
    const float rstd = 1.0f / sqrtf(wave_sum(s) * (1.f / 1024.f) + EPS);
    GAS unsigned long long* o8 = (GAS unsigned long long*)orow + lane;
#pragma unroll
    for (int j = 0; j < 4; ++j) { const f32x4 gg = gr[64 * j];
        o8[64 * j] = (unsigned long long)pk2(v[j].x * rstd * gg.x, v[j].y * rstd * gg.y) | ((unsigned long long)pk2(v[j].z * rstd * gg.z, v[j].w * rstd * gg.w) << 32); }
}
__device__ __forceinline__ void sincos_acc(float ang, float& c, float& s) {
    const double x = (double)ang;
    const double q = __builtin_rint(x * 0.63661977236758134308);
    double y = __builtin_fma(-q, 1.57079632679489655800e+00, x); y = __builtin_fma(-q, 6.12323399573676603587e-17, y);
    const double y2 = y * y;
    double sp = -1.0 / 1307674368000.0; sp = sp * y2 + 1.0 / 6227020800.0; sp = sp * y2 - 1.0 / 39916800.0; sp = sp * y2 + 1.0 / 362880.0; sp = sp * y2 - 1.0 / 5040.0; sp = sp * y2 + 1.0 / 120.0; sp = sp * y2 - 1.0 / 6.0; sp = sp * y2 * y + y;
    double cp = 1.0 / 20922789888000.0; cp = cp * y2 - 1.0 / 87178291200.0; cp = cp * y2 + 1.0 / 479001600.0; cp = cp * y2 - 1.0 / 3628800.0; cp = cp * y2 + 1.0 / 40320.0; cp = cp * y2 - 1.0 / 720.0; cp = cp * y2 + 1.0 / 24.0; cp = cp * y2 - 0.5; cp = cp * y2 + 1.0;
    const int n = (int)q & 3;
    const double ss = (n & 1) ? cp : sp, cc = (n & 1) ? sp : cp;
    s = (float)((n & 2) ? -ss : ss); c = (float)(((n + 1) & 2) ? -cc : cc);
}
__device__ __forceinline__ void p0_prologue(Frame& F) {
    LAS float* scr = (LAS float*)(F.lds + RING_OFF + F.wave * 16384);
    const int gw = F.vcu * NWAVES + F.wave, NGW = F.G * NWAVES;
    constexpr int I_FOLD = 16 * 24, I_IN0 = 16 * 40, I_MKV = 16 * 16, I_OUT = 16 * 32, I_IN1 = 16 * 64, I_UQ = 6 * 40, I_UKV = 4 * 48;
    constexpr int NITEMS = I_FOLD + I_IN0 + 2 * I_MKV + 2 * I_OUT + I_IN1 + I_UQ + I_UKV;
    for (int it = gw; it < NITEMS; it += NGW) {
        int r = it;
        if (r < I_FOLD) { p0_fold_item(F.pool_w_in, F.pool_w_group, F.pool_scale, F.WIN0, scr, r, F.lane); continue; } r -= I_FOLD;
        if (r < I_IN0) { p0_transpose_item<0>(F.pool_w_in, 2048, 768, 1280, 1024, 1280, nullptr, F.WIN0 + (size_t)768 * 1024, scr, r, F.lane); continue; } r -= I_IN0;
        if (r < I_MKV) { p0_transpose_item<0>(F.w_mem_kv, 512, 0, 512, 1024, 512, nullptr, F.WMKV, scr, r, F.lane); continue; } r -= I_MKV;
        if (r < I_MKV) { p0_transpose_item<0>(F.w_mem_kv + (size_t)1024 * 512, 512, 0, 512, 1024, 512, nullptr, F.WMKV + (size_t)512 * 1024, scr, r, F.lane); continue; } r -= I_MKV;
        if (r < I_OUT) { p0_transpose_item<0>(F.w_out, 1024, 0, 1024, 1024, 1024, nullptr, F.WOUT0, scr, r, F.lane); continue; } r -= I_OUT;
        if (r < I_OUT) { p0_transpose_item<0>(F.w_out + (size_t)1024 * 1024, 1024, 0, 1024, 1024, 1024, nullptr, F.WOUT1, scr, r, F.lane); continue; } r -= I_OUT;
        if (r < I_IN1) { p0_transpose_item<1>(F.mla_w_in, 1984, 0, 1984, 1024, 2048, F.norm_g + 1024, F.WIN1, scr, r, F.lane); continue; } r -= I_IN1;
        if (r < I_UQ) { p0_transpose_item<2>(F.mla_w_uq, 1152, 0, 1152, 384, 1280, F.mla_q_norm_g, F.WUQ, scr, r, F.lane); continue; } r -= I_UQ;
        p0_transpose_item<0>(F.mla_w_ukv, 1536, 0, 1536, 256, 1536, F.mla_kv_norm_g, F.WUKV, scr, r, F.lane);
    }
    for (int m = gw; m < M; m += NGW) rms_row_to_bf16(F.x + (size_t)m * DM, F.norm_g, F.XN + (size_t)m * DM, F.lane);
    for (int m = gw; m < MROWS; m += NGW) rms_row_to_bf16(F.mem + (size_t)m * DM, F.mem_norm_g, F.MN + (size_t)m * DM, F.lane);
    for (int e = F.vcu * NWAVES * 64 + F.tid; e < M * 32; e += F.G * NWAVES * 64) {
        const int tok = e >> 5, i = e & 31;
        const float inv = __builtin_amdgcn_exp2f(-(float)(2 * i) * (1.0f / 64.0f) * 13.287712379549449f);
        const float ang = (float)F.positions[tok] * inv;
        float c, s; sincos_acc(ang, c, s);
        *(GAS f32x2*)(F.CS + (size_t)e * 2) = (f32x2){c, s};
    }
}

struct EpiP1 {
    static constexpr bool PERM = true;
    bf16_t* proj; bf16_t* memkv;
    __device__ __forceinline__ void operator()(const f32x4 (&acc)[2][2][4][2], const pg8::Unit& u, int wr, int wc, int fr, int fq) const {
        const int row0 = u.pm * 256 + wr * 64 + fr, col0 = u.pn * 256 + wc * 32 + 8 * fq;
        bf16_t* base = u.g ? memkv : proj; const int ld = u.g ? 1024 : PLD;
        const int kind = u.g ? 0 : (u.pn < 3 ? 0 : (u.pn == 3 ? 1 : 2));
#pragma unroll
        for (int ai = 0; ai < 2; ++ai)
#pragma unroll
            for (int m = 0; m < 4; ++m) { bf16_t* rowp = base + (size_t)(row0 + ai * 128 + m * 16) * ld + col0;
#pragma unroll
                for (int bj = 0; bj < 2; ++bj) { f32x4 v0 = acc[ai][bj][m][0], v1 = acc[ai][bj][m][1];
                    if (kind == 1) { v0 = v0 * MQ_C2; v1 = v1 * MQ_C2; }
                    else if (kind == 2) {
#pragma unroll
                        for (int e = 0; e < 4; ++e) { v0[e] = silu_f(v0[e]); v1[e] = silu_f(v1[e]); } }
                    u32x4 w; w.x = cvt_pk_bf16(v0[0], v0[1]); w.y = cvt_pk_bf16(v0[2], v0[3]); w.z = cvt_pk_bf16(v1[0], v1[1]); w.w = cvt_pk_bf16(v1[2], v1[3]);
                    *(u32x4*)(rowp + bj * 128) = w; } }
    }
};
struct EpiOut {
    static constexpr bool PERM = false;
    const float* base; float* out; bf16_t* outb; float* ssq;
    __device__ __forceinline__ void operator()(const f32x4 (&acc)[2][2][4][2], const pg8::Unit& u, int wr, int wc, int fr, int fq) const {
        const int col0 = u.pn * 256 + wc * 32 + 4 * fq;
#pragma unroll
        for (int ai = 0; ai < 2; ++ai)
#pragma unroll
            for (int m = 0; m < 4; ++m) { const int row = u.pm * 256 + ai * 128 + wr * 64 + m * 16 + fr; const size_t off = (size_t)row * DM + col0; float s = 0.f;
#pragma unroll
                for (int bj = 0; bj < 2; ++bj)
#pragma unroll
                    for (int n = 0; n < 2; ++n) { const f32x4 h = *(const f32x4*)(base + off + bj * 128 + n * 16) + acc[ai][bj][m][n];
                        *(f32x4*)(out + off + bj * 128 + n * 16) = h; s += (h[0] * h[0] + h[1] * h[1]) + (h[2] * h[2] + h[3] * h[3]);
                        if (outb) { u32x2 w; w.x = cvt_pk_bf16(h[0], h[1]); w.y = cvt_pk_bf16(h[2], h[3]); *(u32x2*)(outb + off + bj * 128 + n * 16) = w; } }
                s += __shfl_xor(s, 16); s += __shfl_xor(s, 32);
                if (fq == 0) atomicAdd(ssq + row, s); }
    }
};
__device__ __forceinline__ f32x4 rope4(f32x4 v, f32x4 cs) { return (f32x4){v[0] * cs[0] - v[1] * cs[1], v[1] * cs[0] + v[0] * cs[1], v[2] * cs[2] - v[3] * cs[3], v[3] * cs[2] + v[2] * cs[3]}; }
struct EpiP4 {
    static constexpr bool PERM = true;
    bf16_t* proj; const float* ssq1; float* ssq_q; float* ssq_kv; const float* cs;
    __device__ __forceinline__ void operator()(const f32x4 (&acc)[2][2][4][2], const pg8::Unit& u, int wr, int wc, int fr, int fq) const {
        const int row0 = u.pm * 256 + wr * 64 + fr;
#pragma unroll
        for (int bj = 0; bj < 2; ++bj) {
            const int cw = u.pn * 256 + bj * 128 + wc * 32;
            const int kind = cw < L1_CKV ? 0 : cw < L1_KR ? 1 : cw < L1_MQ ? 2 : cw < L1_GATE ? 3 : cw < L1_END ? 4 : 5;
            if (kind == 5) continue;
            const int col0 = cw + 8 * fq;
#pragma unroll
            for (int ai = 0; ai < 2; ++ai)
#pragma unroll
                for (int m = 0; m < 4; ++m) { const int row = row0 + ai * 128 + m * 16;
                    const float r = 1.0f / sqrtf(ssq1[row] * (1.f / 1024.f) + EPS);
                    f32x4 v0 = acc[ai][bj][m][0] * r, v1 = acc[ai][bj][m][1] * r;
                    if (kind <= 1) { float s = (v0[0] * v0[0] + v0[1] * v0[1]) + (v0[2] * v0[2] + v0[3] * v0[3]) + (v1[0] * v1[0] + v1[1] * v1[1]) + (v1[2] * v1[2] + v1[3] * v1[3]);
                        s += __shfl_xor(s, 16); s += __shfl_xor(s, 32); if (fq == 0) atomicAdd((kind == 0 ? ssq_q : ssq_kv) + row, s); }
                    else if (kind == 2) { const int i0 = (col0 - L1_KR) >> 1; const f32x4* cp = (const f32x4*)(cs + ((size_t)row * 32 + i0) * 2); v0 = rope4(v0, cp[0]); v1 = rope4(v1, cp[1]); }
                    else if (kind == 3) { v0 = v0 * MQ_C2; v1 = v1 * MQ_C2; }
                    else {
#pragma unroll
                        for (int e = 0; e < 4; ++e) { v0[e] = silu_f(v0[e]); v1[e] = silu_f(v1[e]); } }
                    u32x4 w; w.x = cvt_pk_bf16(v0[0], v0[1]); w.y = cvt_pk_bf16(v0[2], v0[3]); w.z = cvt_pk_bf16(v1[0], v1[1]); w.w = cvt_pk_bf16(v1[2], v1[3]);
                    *(u32x4*)(proj + (size_t)row * PLD + col0) = w; asm volatile("" ::: "memory"); }
        }
    }
};
struct EpiQ {
    static constexpr bool PERM = true;
    bf16_t* q; const float* ssq_q; const float* cs;
    __device__ __forceinline__ void operator()(const f32x4 (&acc)[2][2][4][2], const pg8::Unit& u, int wr, int wc, int fr, int fq) const {
        const int row0 = u.pm * 256 + wr * 64 + fr;
#pragma unroll
        for (int bj = 0; bj < 2; ++bj) {
            const int col0 = u.pn * 256 + bj * 128 + wc * 32 + 8 * fq;
            if (u.pn * 256 + bj * 128 >= QLD) continue;
            const int d = col0 % 192; const bool rope = d >= 128; const int i0 = rope ? (d - 128) >> 1 : 0;
#pragma unroll
            for (int ai = 0; ai < 2; ++ai)
#pragma unroll
                for (int m = 0; m < 4; ++m) { const int row = row0 + ai * 128 + m * 16;
                    const float r = Q_C2 / sqrtf(ssq_q[row] * (1.f / 384.f) + EPS);
                    f32x4 v0 = acc[ai][bj][m][0] * r, v1 = acc[ai][bj][m][1] * r;
                    if (rope) { const f32x4* cp = (const f32x4*)(cs + ((size_t)row * 32 + i0) * 2); v0 = rope4(v0, cp[0]); v1 = rope4(v1, cp[1]); }
                    u32x4 w; w.x = cvt_pk_bf16(v0[0], v0[1]); w.y = cvt_pk_bf16(v0[2], v0[3]); w.z = cvt_pk_bf16(v1[0], v1[1]); w.w = cvt_pk_bf16(v1[2], v1[3]);
                    *(u32x4*)(q + (size_t)row * QLD + col0) = w; asm volatile("" ::: "memory"); }
        }
    }
};
struct EpiKV {
    static constexpr bool PERM = true;
    bf16_t* kn; bf16_t* vv; const float* ssq_kv;
    __device__ __forceinline__ void operator()(const f32x4 (&acc)[2][2][4][2], const pg8::Unit& u, int wr, int wc, int fr, int fq) const {
        const int row0 = u.pm * 256 + wr * 64 + fr, col0 = u.pn * 128 + wc * 32 + 8 * fq;
#pragma unroll
        for (int ai = 0; ai < 2; ++ai)
#pragma unroll
            for (int m = 0; m < 4; ++m) { const int row = row0 + ai * 128 + m * 16;
                const float r = 1.0f / sqrtf(ssq_kv[row] * (1.f / 256.f) + EPS);
#pragma unroll
                for (int bj = 0; bj < 2; ++bj) { const f32x4 v0 = acc[ai][bj][m][0] * r, v1 = acc[ai][bj][m][1] * r;
                    u32x4 w; w.x = cvt_pk_bf16(v0[0], v0[1]); w.y = cvt_pk_bf16(v0[2], v0[3]); w.z = cvt_pk_bf16(v1[0], v1[1]); w.w = cvt_pk_bf16(v1[2], v1[3]);
                    *(u32x4*)((bj ? vv : kn) + (size_t)row * KLD + col0) = w; } asm volatile("" ::: "memory"); }
    }
};

__device__ __forceinline__ void pool_phase(Frame& F) {
    const int gtid = F.vcu * NWAVES * 64 + F.tid, NT = F.G * NWAVES * 64;
    for (int e = gtid; e < M * 96; e += NT) {
        const int t = e / 96, cc = e - t * 96, c = cc * 8, g = c / 192, w = 2 << g, s = t & (SEQ - 1), cnt = (s + 1 < w) ? s + 1 : w;
        float sum[8];
#pragma unroll
        for (int k = 0; k < 8; ++k) sum[k] = 0.f;
        const bf16_t* zp = F.PROJ + (size_t)t * PLD + c;
        u32x4 z0 = *(const u32x4*)zp;
        for (int j = 0; j < cnt; ++j) { const u32x4 zz = *(const u32x4*)(zp - (size_t)j * PLD);
            sum[0] += bflo(zz.x); sum[1] += bfhi(zz.x); sum[2] += bflo(zz.y); sum[3] += bfhi(zz.y); sum[4] += bflo(zz.z); sum[5] += bfhi(zz.z); sum[6] += bflo(zz.w); sum[7] += bfhi(zz.w); }
        const float ic = 1.0f / (float)cnt;
        const u32x4 gg = *(const u32x4*)(F.PROJ + (size_t)t * PLD + L0_GATE + c);
        float o[8];
        o[0] = (sum[0] * ic - bflo(z0.x)) * bflo(gg.x); o[1] = (sum[1] * ic - bfhi(z0.x)) * bfhi(gg.x);
        o[2] = (sum[2] * ic - bflo(z0.y)) * bflo(gg.y); o[3] = (sum[3] * ic - bfhi(z0.y)) * bfhi(gg.y);
        o[4] = (sum[4] * ic - bflo(z0.z)) * bflo(gg.z); o[5] = (sum[5] * ic - bfhi(z0.z)) * bfhi(gg.z);
        o[6] = (sum[6] * ic - bflo(z0.w)) * bflo(gg.w); o[7] = (sum[7] * ic - bfhi(z0.w)) * bfhi(gg.w);
        u32x4 w4; w4.x = pk2(o[0], o[1]); w4.y = pk2(o[2], o[3]); w4.z = pk2(o[4], o[5]); w4.w = pk2(o[6], o[7]);
        *(u32x4*)(F.BR + (size_t)t * DM + c) = w4;
    }
}
__device__ __forceinline__ void memattn_naive(Frame& F, int layer, int mq_col, int gate_col) {
    const int gw = F.vcu * NWAVES + F.wave, NGW = F.G * NWAVES, lane = F.lane;
    for (int it = gw; it < M * 4; it += NGW) {
        const int t = it >> 2, h = it & 3, b = t / SEQ;
        const bf16_t* qp = F.PROJ + (size_t)t * PLD + mq_col + h * 64;
        float q[64];
#pragma unroll
        for (int c = 0; c < 8; ++c) { const u32x4 w = *(const u32x4*)(qp + 8 * c);
            q[8 * c] = bflo(w.x); q[8 * c + 1] = bfhi(w.x); q[8 * c + 2] = bflo(w.y); q[8 * c + 3] = bfhi(w.y); q[8 * c + 4] = bflo(w.z); q[8 * c + 5] = bfhi(w.z); q[8 * c + 6] = bflo(w.w); q[8 * c + 7] = bfhi(w.w); }
        const bf16_t* kb = F.MEMKV + (size_t)(b * NMEM) * 1024 + layer * 512 + h * 64;
        float sc[4];
#pragma unroll
        for (int j = 0; j < 4; ++j) { const bf16_t* kp = kb + (size_t)(j * 64 + lane) * 1024; float a = 0.f;
#pragma unroll
            for (int c = 0; c < 8; ++c) { const u32x4 w = *(const u32x4*)(kp + 8 * c);
                a += q[8 * c] * bflo(w.x) + q[8 * c + 1] * bfhi(w.x) + q[8 * c + 2] * bflo(w.y) + q[8 * c + 3] * bfhi(w.y) + q[8 * c + 4] * bflo(w.z) + q[8 * c + 5] * bfhi(w.z) + q[8 * c + 6] * bflo(w.w) + q[8 * c + 7] * bfhi(w.w); }
            sc[j] = a; }
        const float mx = wave_max(fmaxf(fmaxf(sc[0], sc[1]), fmaxf(sc[2], sc[3])));
        float p[4], ls = 0.f;
#pragma unroll
        for (int j = 0; j < 4; ++j) { p[j] = __builtin_amdgcn_exp2f(sc[j] - mx); ls += p[j]; }
        const float l = wave_sum(ls);
        const bf16_t* vb = kb + 256 + lane; float o = 0.f;
#pragma unroll
        for (int j = 0; j < 4; ++j)
            for (int s = 0; s < 64; ++s) { const float pp = __shfl(p[j], s); o += pp * bf2f(vb[(size_t)(j * 64 + s) * 1024]); }
        const float gt = bf2f(F.PROJ[(size_t)t * PLD + gate_col + 768 + h * 64 + lane]);
        F.BR[(size_t)t * DM + 768 + h * 64 + lane] = (bf16_t)f2bf(o / l * gt);
    }
}
__device__ __forceinline__ void mla_naive(Frame& F) {
    const int gw = F.vcu * NWAVES + F.wave, NGW = F.G * NWAVES, lane = F.lane, sub = lane & 7, kq = lane >> 3;
    LAS float* scs = (LAS float*)(F.lds + RING_OFF) + F.wave * 2048;
    for (int it = gw; it < M * 6; it += NGW) {
        const int h = it % 6, t = it / 6, b = t / SEQ, s = t & (SEQ - 1), nk = ((s >> 6) + 1) * 64;
        const bf16_t* qp = F.Q + (size_t)t * QLD + h * 192;
        float q[24];
        { const u32x4 w0 = *(const u32x4*)(qp + 8 * sub), w1 = *(const u32x4*)(qp + 64 + 8 * sub), w2 = *(const u32x4*)(qp + 128 + 8 * sub);
          q[0] = bflo(w0.x); q[1] = bfhi(w0.x); q[2] = bflo(w0.y); q[3] = bfhi(w0.y); q[4] = bflo(w0.z); q[5] = bfhi(w0.z); q[6] = bflo(w0.w); q[7] = bfhi(w0.w);
          q[8] = bflo(w1.x); q[9] = bfhi(w1.x); q[10] = bflo(w1.y); q[11] = bfhi(w1.y); q[12] = bflo(w1.z); q[13] = bfhi(w1.z); q[14] = bflo(w1.w); q[15] = bfhi(w1.w);
          q[16] = bflo(w2.x); q[17] = bfhi(w2.x); q[18] = bflo(w2.y); q[19] = bfhi(w2.y); q[20] = bflo(w2.z); q[21] = bfhi(w2.z); q[22] = bflo(w2.w); q[23] = bfhi(w2.w); }
        const size_t r0 = (size_t)b * SEQ;
        float mx = -3.0e38f;
        for (int kg = 0; kg < nk; kg += 8) { const int key = kg + kq;
            const bf16_t* kn = F.KN + (r0 + key) * KLD + h * 128 + 8 * sub; const bf16_t* kr = F.PROJ + (r0 + key) * PLD + L1_KR + 8 * sub;
            const u32x4 w0 = *(const u32x4*)kn, w1 = *(const u32x4*)(kn + 64), w2 = *(const u32x4*)kr;
            float a = q[0] * bflo(w0.x) + q[1] * bfhi(w0.x) + q[2] * bflo(w0.y) + q[3] * bfhi(w0.y) + q[4] * bflo(w0.z) + q[5] * bfhi(w0.z) + q[6] * bflo(w0.w) + q[7] * bfhi(w0.w);
            a += q[8] * bflo(w1.x) + q[9] * bfhi(w1.x) + q[10] * bflo(w1.y) + q[11] * bfhi(w1.y) + q[12] * bflo(w1.z) + q[13] * bfhi(w1.z) + q[14] * bflo(w1.w) + q[15] * bfhi(w1.w);
            a += q[16] * bflo(w2.x) + q[17] * bfhi(w2.x) + q[18] * bflo(w2.y) + q[19] * bfhi(w2.y) + q[20] * bflo(w2.z) + q[21] * bfhi(w2.z) + q[22] * bflo(w2.w) + q[23] * bfhi(w2.w);
            a += __shfl_xor(a, 1); a += __shfl_xor(a, 2); a += __shfl_xor(a, 4);
            mx = fmaxf(mx, a);
            if (sub == 0) scs[key] = a; }
        mx = wave_max(mx);
        LDS_WAIT(); asm volatile("" ::: "memory");
        float ls = 0.f;
        for (int k = lane; k < nk; k += 64) { const float p = __builtin_amdgcn_exp2f(scs[k] - mx); scs[k] = p; ls += p; }
        const float l = wave_sum(ls);
        LDS_WAIT(); asm volatile("" ::: "memory");
        const bf16_t* vp = F.VV + r0 * KLD + h * 128 + 2 * lane; float o0 = 0.f, o1 = 0.f;
        for (int k = 0; k < nk; ++k) { const float p = scs[k]; const unsigned w = *(const unsigned*)(vp + (size_t)k * KLD); o0 += p * bflo(w); o1 += p * bfhi(w); }
        const unsigned gw2 = *(const unsigned*)(F.PROJ + (size_t)t * PLD + L1_GATE + h * 128 + 2 * lane);
        const float il = 1.0f / l;
        *(unsigned*)(F.BR + (size_t)t * DM + h * 128 + 2 * lane) = pk2(o0 * il * bflo(gw2), o1 * il * bfhi(gw2));
        LDS_WAIT(); asm volatile("" ::: "memory");
    }
}
__device__ __forceinline__ void final_norm(Frame& F) {
    const int gw = F.vcu * NWAVES + F.wave, NGW = F.G * NWAVES;
    for (int m = gw; m < M; m += NGW) {
        const float r = 1.0f / sqrtf(F.ssq2[m] * (1.f / 1024.f) + EPS);
        GAS f32x4* o = (GAS f32x4*)(F.out + (size_t)m * DM) + F.lane; const GAS f32x4* g = (const GAS f32x4*)F.final_norm_g + F.lane;
#pragma unroll
        for (int j = 0; j < 4; ++j) { const f32x4 v = o[64 * j], gg = g[64 * j]; o[64 * j] = (f32x4){v.x * r * gg.x, v.y * r * gg.y, v.z * r * gg.z, v.w * r * gg.w}; }
    }
}

struct Args { const void* in[16]; float* out; unsigned char* ws; int ph_lo, ph_hi; };
constexpr int N_PHASES = 9;
__global__ void __launch_bounds__(NWAVES * 64, 2) trunk_fwd(Args args) {
    extern __shared__ __attribute__((aligned(16))) unsigned char lds[];
    Frame F;
    F.lds = (LAS unsigned char*)lds;
    F.MISC = (volatile LAS unsigned*)(F.lds + MISC_OFF);
    F.tid = threadIdx.x; F.lane = F.tid & 63; F.wave = __builtin_amdgcn_readfirstlane(F.tid >> 6);
    F.G = gridDim.x; { const int bx = blockIdx.x; F.vcu = (F.G % 8 == 0) ? (bx % 8) * (F.G / 8) + bx / 8 : bx; }
    unsigned char* ws = args.ws;
    F.ctl = (gu32*)(ws + WS_CTL);
    F.x = (const float*)args.in[0]; F.mem = (const float*)args.in[1]; F.positions = (const int*)args.in[2]; F.norm_g = (const float*)args.in[3]; F.mem_norm_g = (const float*)args.in[4];
    F.w_mem_kv = (const float*)args.in[5]; F.w_out = (const float*)args.in[6]; F.pool_w_in = (const float*)args.in[7]; F.pool_w_group = (const float*)args.in[8]; F.pool_scale = (const float*)args.in[9];
    F.mla_w_in = (const float*)args.in[10]; F.mla_q_norm_g = (const float*)args.in[11]; F.mla_w_uq = (const float*)args.in[12]; F.mla_kv_norm_g = (const float*)args.in[13]; F.mla_w_ukv = (const float*)args.in[14];
    F.final_norm_g = (const float*)args.in[15]; F.out = args.out;
    F.WIN0 = (bf16_t*)(ws + WS_WIN0); F.WMKV = (bf16_t*)(ws + WS_WMKV); F.WOUT0 = (bf16_t*)(ws + WS_WOUT0); F.WOUT1 = (bf16_t*)(ws + WS_WOUT1); F.WIN1 = (bf16_t*)(ws + WS_WIN1);
    F.WUQ = (bf16_t*)(ws + WS_WUQ); F.WUKV = (bf16_t*)(ws + WS_WUKV);
    F.XN = (bf16_t*)(ws + WS_XN); F.MN = (bf16_t*)(ws + WS_MN); F.MEMKV = (bf16_t*)(ws + WS_MEMKV); F.PROJ = (bf16_t*)(ws + WS_PROJ); F.BR = (bf16_t*)(ws + WS_BR);
    F.Q = (bf16_t*)(ws + WS_Q); F.KN = (bf16_t*)(ws + WS_KN); F.VV = (bf16_t*)(ws + WS_VV);
    F.CS = (float*)(ws + WS_CS); F.ssq1 = (float*)(ws + WS_SSQ); F.ssq_q = F.ssq1 + M; F.ssq_kv = F.ssq_q + M; F.ssq2 = F.ssq_kv + M;
    for (int u = F.tid; u < (LDS_BYTES - LDSCTL_OFF) / 4; u += NWAVES * 64) ((LAS unsigned*)(F.lds + LDSCTL_OFF))[u] = 0u;
    __syncthreads();
    const int lo = args.ph_lo, hi = args.ph_hi;
    XcdBarrier bar; bar.bar = (unsigned*)(F.ctl + CW_BAR); bar.x = 0; bar.st = nullptr;
    if (hi - lo > 1) bar = xcd_barrier_post((unsigned*)(F.ctl + CW_BAR), F.MISC + 8);
#ifndef PHASE_MASK
#define PHASE_MASK 0x1ff
#endif
#define IN(k) (((PHASE_MASK >> (k)) & 1) && lo <= (k) && (k) < hi)
#define SEAM(k) do { if (IN(k) && IN((k) + 1)) xcd_barrier(bar); } while (0)
    const int bx = (int)blockIdx.x;
    if (IN(0)) { p0_prologue(F); SEAM(0); }
    if (IN(1)) {
        pg8::Sched2 S{F.XN, F.WIN0, F.MN, F.WMKV, M, 2048, MROWS, 1024, 1024, 1024, F.G, bx};
        EpiP1 E{F.PROJ, F.MEMKV};
        pg8::gemm_phase(F.lds + RING_OFF, 1024, 1024, 1024, S, E);
        SEAM(1);
    }
    if (IN(2)) { pool_phase(F); memattn_naive(F, 0, L0_MQ, L0_GATE); SEAM(2); }
    if (IN(3)) {
        pg8::Sched1 S{F.BR, F.WOUT0, M, 1024, 1024, 1024, F.G, bx};
        EpiOut E{F.x, F.out, F.XN, F.ssq1};
        pg8::gemm_phase(F.lds + RING_OFF, 1024, 1024, 1024, S, E);
        SEAM(3);
    }
    if (IN(4)) {
        pg8::Sched1 S{F.XN, F.WIN1, M, 2048, 1024, 1024, F.G, bx};
        EpiP4 E{F.PROJ, F.ssq1, F.ssq_q, F.ssq_kv, F.CS};
        pg8::gemm_phase(F.lds + RING_OFF, 1024, 1024, 1024, S, E);
        SEAM(4);
    }
    if (IN(5)) {
        { pg8::Sched1 S{F.PROJ, F.WUQ, M, 1280, PLD, 384, F.G, bx}; EpiQ E{F.Q, F.ssq_q, F.CS};
          pg8::gemm_phase(F.lds + RING_OFF, 384, PLD, 384, S, E); }
        { pg8::Sched1 S{F.PROJ + L1_CKV, F.WUKV, M, 1536, PLD, 256, F.G, bx}; EpiKV E{F.KN, F.VV, F.ssq_kv};
          pg8::gemm_phase(F.lds + RING_OFF, 256, PLD, 256, S, E); }
        SEAM(5);
    }
    if (IN(6)) { mla_naive(F); memattn_naive(F, 1, L1_MQ, L1_GATE); SEAM(6); }
    if (IN(7)) {
        pg8::Sched1 S{F.BR, F.WOUT1, M, 1024, 1024, 1024, F.G, bx};
        EpiOut E{F.out, F.out, nullptr, F.ssq2};
        pg8::gemm_phase(F.lds + RING_OFF, 1024, 1024, 1024, S, E);
        SEAM(7);
    }
    if (IN(8)) { final_norm(F); }
#undef IN
#undef SEAM
}

extern "C" void kernel_launch(void* const* d_in, const int* in_sizes, int n_in, void* d_out, int out_size, void* d_ws, size_t ws_size, hipStream_t stream) {
    static int grid = 0;
    if (grid == 0) {
        if (n_in != 16 || in_sizes[0] != M * DM || out_size != M * DM || ws_size < WS_END) { fprintf(stderr, "kernel_launch: unexpected shapes (n_in %d, in0 %d, out %d, ws %zu); nothing launched\n", n_in, n_in > 0 ? in_sizes[0] : -1, out_size, ws_size); grid = -1; return; }
        int dev = 0, cus = 0, per_cu = 0;
        if (hipGetDevice(&dev) != hipSuccess || hipDeviceGetAttribute(&cus, hipDeviceAttributeMultiprocessorCount, dev) != hipSuccess) { grid = -1; return; }
        if (hipFuncSetAttribute((const void*)trunk_fwd, hipFuncAttributeMaxDynamicSharedMemorySize, LDS_BYTES) != hipSuccess) { fprintf(stderr, "kernel_launch: hipFuncSetAttribute failed\n"); grid = -1; return; }
        if (hipOccupancyMaxActiveBlocksPerMultiprocessor(&per_cu, (const void*)trunk_fwd, NWAVES * 64, LDS_BYTES) != hipSuccess || per_cu < 1) { fprintf(stderr, "kernel_launch: occupancy query says %d blocks per CU; nothing launched\n", per_cu); (void)hipGetLastError(); grid = -1; return; }
        grid = cus;
    }
    if (grid < 0) return;
    (void)hipMemsetAsync((char*)d_ws + WS_CTL, 0, CTL_ZERO_BYTES, stream);
    Args a{};
    for (int i = 0; i < 16; ++i) a.in[i] = d_in[i];
    a.out = (float*)d_out; a.ws = (unsigned char*)d_ws;
    if (MK_N_LAUNCHES == 1) { a.ph_lo = 0; a.ph_hi = N_PHASES; hipLaunchKernelGGL(trunk_fwd, dim3(grid), dim3(NWAVES * 64), LDS_BYTES, stream, a); }
    else for (int p = 0; p < N_PHASES; ++p) { a.ph_lo = p; a.ph_hi = p + 1; hipLaunchKernelGGL(trunk_fwd, dim3(grid), dim3(NWAVES * 64), LDS_BYTES, stream, a); }
}
```

```cpp
#include <hip/hip_runtime.h>
#include <cstdio>
#include <cstdint>

#ifndef MK_N_LAUNCHES
#define MK_N_LAUNCHES 1
#endif

#define LAS __attribute__((address_space(3)))
#define GAS __attribute__((address_space(1)))
typedef unsigned short bf16_t;
typedef short bf16x8 __attribute__((ext_vector_type(8)));
typedef float f32x4 __attribute__((ext_vector_type(4)));
typedef float f32x2 __attribute__((ext_vector_type(2)));
typedef unsigned u32x4 __attribute__((ext_vector_type(4)));
typedef unsigned u32x2 __attribute__((ext_vector_type(2)));
typedef GAS unsigned gu32;

constexpr int BATCH = 16, SEQ = 2048, DM = 1024, M = BATCH * SEQ;
constexpr int NMEM = 256, MROWS = BATCH * NMEM;
constexpr int PLD = 2048;
constexpr int L0_MQ = 768, L0_GATE = 1024;
constexpr int L1_CKV = 384, L1_KR = 640, L1_MQ = 704, L1_GATE = 960, L1_END = 1984;
constexpr int QLD = 1152, KLD = 768;
constexpr float EPS = 1e-6f, LOG2E = 1.4426950408889634f;
constexpr float MQ_C2 = 0.125f * LOG2E;
constexpr float Q_C2 = 0.07216878364870323f * LOG2E;

constexpr size_t MiB = 1u << 20;
constexpr size_t WS_CTL = 0, CTL_ZERO_BYTES = 2 * MiB;
constexpr size_t WS_SSQ = 1 * MiB;
constexpr size_t WS_WIN0 = 2 * MiB, WS_WMKV = 6 * MiB, WS_WOUT0 = 8 * MiB, WS_WOUT1 = 10 * MiB, WS_WIN1 = 12 * MiB, WS_WUQ = 16 * MiB, WS_WUKV = 17 * MiB;
constexpr size_t WS_CS = 18 * MiB, WS_MN = 26 * MiB, WS_MEMKV = 34 * MiB;
constexpr size_t WS_XN = 48 * MiB;
constexpr size_t WS_PROJ = 112 * MiB, WS_BR = 240 * MiB, WS_Q = 304 * MiB, WS_KN = 376 * MiB, WS_VV = 424 * MiB, WS_END = 472 * MiB;
constexpr int CW_BAR = 4096, CW_QHEAD = 64;

namespace pg8 {
constexpr int BM = 256, BK = 64, HALF = 128, HTB = HALF * BK * 2, STAGE_BYTES = 8 * HTB, NXCD = 8, WGM = 8;
__host__ __device__ __forceinline__ int lds_byte(int r, int c) { const int st = (r >> 4) * 2 + (c >> 5), rr = r & 15, cc = c & 31, ob = rr * 64 + cc * 2; return st * 1024 + (ob ^ (((ob >> 9) & 1) << 5)); }
__host__ __device__ __forceinline__ void stage_rc(int b, int& R, int& C) { const int st = b / 1024, sb = b % 1024, swz = sb ^ (((sb >> 9) & 1) << 5); R = (st >> 1) * 16 + swz / 64; C = (st & 1) * 32 + (swz % 64) / 2; }
__host__ __device__ __forceinline__ int perm32(int rho) { const int n = rho >> 4, i = rho & 15; return 8 * (i >> 2) + 4 * n + (i & 3); }

struct Unit { int pm, pn, g; };
__device__ __forceinline__ int static_unit(int M_, int N_, int L) {
    const int nM = M_ / BM, nN = N_ / BM, nwg = nM * nN;
    int wgid = L; { const int q = nwg / NXCD, r = nwg % NXCD, xcd = wgid % NXCD, off = wgid / NXCD; wgid = (xcd < r ? xcd * (q + 1) : r * (q + 1) + (xcd - r) * q) + off; }
    const int nig = WGM * nN, gid = wgid / nig, fm = gid * WGM, gsz = (nM - fm) < WGM ? (nM - fm) : WGM;
    return ((fm + ((wgid % nig) % gsz)) << 16) | ((wgid % nig) / gsz);
}
struct Sched1 {
    const bf16_t* A; const bf16_t* Bt; int M_, N_, lda, ldb, G, c;
    __device__ __forceinline__ Unit next(int i, bool& ok) const { const int L = i * G + c; ok = L < (M_ / BM) * (N_ / BM); const int p = static_unit(M_, N_, ok ? L : 0); return Unit{p >> 16, p & 0xffff, 0}; }
    __device__ __forceinline__ const char* aptr(const Unit& u) const { return (const char*)(A + (size_t)u.pm * BM * lda); }
    __device__ __forceinline__ const char* bptr(const Unit& u) const { return (const char*)(Bt + (size_t)u.pn * BM * ldb); }
};
struct Sched2 {
    const bf16_t* A0; const bf16_t* B0; const bf16_t* A1; const bf16_t* B1; int M0, N0, M1, N1, lda, ldb, G, c;
    __device__ __forceinline__ Unit next(int i, bool& ok) const {
        const int n0 = (M0 / BM) * (N0 / BM), n1 = (M1 / BM) * (N1 / BM), L = i * G + c; ok = L < n0 + n1;
        const int p = static_unit(M0, N0, L < n0 ? L : 0), r = L - n0, g = L >= n0 ? 1 : 0;
        return Unit{g ? r / (N1 / BM) : (p >> 16), g ? r % (N1 / BM) : (p & 0xffff), g};
    }
    __device__ __forceinline__ const char* aptr(const Unit& u) const { return (const char*)((u.g ? A1 : A0) + (size_t)u.pm * BM * lda); }
    __device__ __forceinline__ const char* bptr(const Unit& u) const { return (const char*)((u.g ? B1 : B0) + (size_t)u.pn * BM * ldb); }
};

template <class Epi, class Sched>
__device__ __forceinline__ void gemm_phase(LAS unsigned char* lds, const int K, const int lda, const int ldb, const Sched& S, const Epi& E) {
    const int tid = threadIdx.x, wid = __builtin_amdgcn_readfirstlane(tid >> 6), lane = tid & 63, wr = wid >> 2, wc = wid & 3, fr = lane & 15, fq = lane >> 4;
    const int nt = K / BK;
    unsigned voffA[2], voffB[2];
#pragma unroll
    for (int i = 0; i < 2; ++i) { int R, C; stage_rc(tid * 16 + i * 8192, R, C); const int Rb = Epi::PERM ? ((R & ~31) + perm32(R & 31)) : R;
        voffA[i] = (unsigned)(R * lda + C) * 2u; voffB[i] = (unsigned)(Rb * ldb + C) * 2u; }
    const size_t kstep = (size_t)(BK * 2);
    const size_t hstepA = (size_t)HALF * lda * 2, hstepB = (size_t)HALF * ldb * 2;
    const unsigned ldsw = (unsigned)wid * 1024u;
    const int aoff = lds_byte(wr * 64 + fr, fq * 8), boff = lds_byte(wc * 32 + fr, fq * 8);
#define PG8_SA(b, h) (((b) * 2 + (h)) * HTB)
#define PG8_SB(b, h) ((4 + (b) * 2 + (h)) * HTB)
#define PG8_STAGE(bufoff, gbase, voff) do { _Pragma("unroll") for (int _i = 0; _i < 2; ++_i) \
        __builtin_amdgcn_global_load_lds((const unsigned*)((const char*)(gbase) + (voff)[_i]), (LAS unsigned*)(lds + (bufoff) + ldsw + _i * 8192), 16, 0, 0); } while (0)
#define PG8_LDA(dst, b, h) do { _Pragma("unroll") for (int m = 0; m < 4; ++m) _Pragma("unroll") for (int k = 0; k < 2; ++k) dst[m][k] = *(const LAS bf16x8*)(lds + PG8_SA(b, h) + aoff + m * 2048 + k * 1024); } while (0)
#define PG8_LDB(dst, b, h) do { _Pragma("unroll") for (int n = 0; n < 2; ++n) _Pragma("unroll") for (int k = 0; k < 2; ++k) dst[n][k] = *(const LAS bf16x8*)(lds + PG8_SB(b, h) + boff + n * 2048 + k * 1024); } while (0)
#define PG8_MMA(ai, bj, At, Bt) do { __builtin_amdgcn_s_setprio(1); _Pragma("unroll") for (int m = 0; m < 4; ++m) _Pragma("unroll") for (int n = 0; n < 2; ++n) _Pragma("unroll") for (int k = 0; k < 2; ++k) \
        acc[ai][bj][m][n] = __builtin_amdgcn_mfma_f32_16x16x32_bf16(Bt[n][k], At[m][k], acc[ai][bj][m][n], 0, 0, 0); __builtin_amdgcn_s_setprio(0); } while (0)
#define PG8_WAIT_V(n) asm volatile("s_waitcnt vmcnt(" #n ")" ::: "memory")
#define PG8_WAIT_L(n) asm volatile("s_waitcnt lgkmcnt(" #n ")" ::: "memory")
#define PG8_BAR __builtin_amdgcn_s_barrier()
#define PG8_SCHED __builtin_amdgcn_sched_barrier(0)
    int ui = 0; bool ok0;
    Unit cur = S.next(0, ok0);
    if (!ok0) return;
    f32x4 acc[2][2][4][2];
#pragma unroll
    for (int a = 0; a < 2; ++a)
#pragma unroll
        for (int b = 0; b < 2; ++b)
#pragma unroll
            for (int m = 0; m < 4; ++m)
#pragma unroll
                for (int n = 0; n < 2; ++n) acc[a][b][m][n] = (f32x4){0.f, 0.f, 0.f, 0.f};
    bf16x8 At[4][2], B0[2][2], B1[2][2];
    const char* cA = S.aptr(cur); const char* cB = S.bptr(cur);
    PG8_STAGE(PG8_SB(0, 0), cB, voffB); PG8_STAGE(PG8_SB(0, 1), cB + hstepB, voffB); PG8_STAGE(PG8_SA(0, 0), cA, voffA); PG8_STAGE(PG8_SA(0, 1), cA + hstepA, voffA);
    if (wr == 1) PG8_BAR;
    PG8_WAIT_V(2); PG8_BAR;
    PG8_STAGE(PG8_SB(1, 0), cB + kstep, voffB); PG8_STAGE(PG8_SA(1, 0), cA + kstep, voffA); PG8_STAGE(PG8_SB(1, 1), cB + hstepB + kstep, voffB);
    PG8_WAIT_V(6); PG8_BAR;
    for (;;) {
        bool has_next; const Unit nxt = S.next(ui + 1, has_next);
        const char* nA = has_next ? S.aptr(nxt) : cA; const char* nB = has_next ? S.bptr(nxt) : cB;
#pragma unroll 1
        for (int t = 0; t < nt; t += 2) {
            const bool last = (t == nt - 2);
            const char* a1 = cA + (size_t)(t + 1) * kstep;
            const char* a2 = last ? nA : cA + (size_t)(t + 2) * kstep; const char* b2 = last ? nB : cB + (size_t)(t + 2) * kstep;
            const char* a3 = a2 + kstep; const char* b3 = b2 + kstep;
            PG8_LDB(B0, 0, 0); PG8_LDB(B1, 0, 1); PG8_SCHED; PG8_LDA(At, 0, 0); PG8_STAGE(PG8_SA(1, 1), a1 + hstepA, voffA);
            PG8_WAIT_V(8); PG8_WAIT_L(0); PG8_BAR; PG8_MMA(0, 0, At, B0); PG8_MMA(0, 1, At, B1); PG8_BAR; PG8_SCHED;
            PG8_LDA(At, 0, 1); PG8_STAGE(PG8_SB(0, 0), b2, voffB); PG8_STAGE(PG8_SB(0, 1), b2 + hstepB, voffB); PG8_STAGE(PG8_SA(0, 0), a2, voffA);
            PG8_WAIT_V(8); PG8_WAIT_L(0); PG8_BAR; PG8_MMA(1, 0, At, B0); PG8_MMA(1, 1, At, B1); PG8_BAR; PG8_SCHED;
            PG8_LDB(B0, 1, 0); PG8_LDB(B1, 1, 1); PG8_SCHED; PG8_LDA(At, 1, 0); PG8_STAGE(PG8_SA(0, 1), a2 + hstepA, voffA);
            PG8_WAIT_V(8); PG8_WAIT_L(0); PG8_BAR; PG8_MMA(0, 0, At, B0); PG8_MMA(0, 1, At, B1); PG8_BAR; PG8_SCHED;
            PG8_LDA(At, 1, 1); PG8_STAGE(PG8_SB(1, 0), b3, voffB); PG8_STAGE(PG8_SB(1, 1), b3 + hstepB, voffB); PG8_STAGE(PG8_SA(1, 0), a3, voffA);
            PG8_WAIT_V(8); PG8_WAIT_L(0); PG8_BAR; PG8_MMA(1, 0, At, B0); PG8_MMA(1, 1, At, B1); PG8_BAR; PG8_SCHED;
        }
        if (wr == 0) PG8_BAR;
        E(acc, cur, wr, wc, fr, fq);
        if (!has_next) break;
#pragma unroll
        for (int a = 0; a < 2; ++a)
#pragma unroll
            for (int b = 0; b < 2; ++b)
#pragma unroll
                for (int m = 0; m < 4; ++m)
#pragma unroll
                    for (int n = 0; n < 2; ++n) acc[a][b][m][n] = (f32x4){0.f, 0.f, 0.f, 0.f};
        cur = nxt; cA = nA; cB = nB; ++ui;
        if (wr == 1) PG8_BAR;
    }
    PG8_WAIT_V(0);
    PG8_BAR;
#undef PG8_SA
#undef PG8_SB
#undef PG8_STAGE
#undef PG8_LDA
#undef PG8_LDB
#undef PG8_MMA
#undef PG8_WAIT_V
#undef PG8_WAIT_L
#undef PG8_BAR
#undef PG8_SCHED
}
}

#define RLX_AGENT __ATOMIC_RELAXED, __HIP_MEMORY_SCOPE_AGENT
#define LDS_WAIT() asm volatile("s_waitcnt lgkmcnt(0)" ::: "memory")
#define VM_WAIT() asm volatile("s_waitcnt vmcnt(0)" ::: "memory")
__device__ __forceinline__ unsigned f2bf(float f) { unsigned u = __builtin_bit_cast(unsigned, f); return (u + 0x7fffu + ((u >> 16) & 1u)) >> 16; }
__device__ __forceinline__ unsigned pk2(float lo, float hi) { return f2bf(lo) | (f2bf(hi) << 16); }
__device__ __forceinline__ float bf2f(unsigned short b) { return __builtin_bit_cast(float, (unsigned)b << 16); }
__device__ __forceinline__ float bflo(unsigned w) { return __builtin_bit_cast(float, w << 16); }
__device__ __forceinline__ float bfhi(unsigned w) { return __builtin_bit_cast(float, w & 0xffff0000u); }
__device__ __forceinline__ unsigned cvt_pk_bf16(float lo, float hi) { unsigned r; asm volatile("v_cvt_pk_bf16_f32 %0, %1, %2" : "=v"(r) : "v"(lo), "v"(hi)); return r; }
__device__ __forceinline__ float silu_f(float x) { return x * __builtin_amdgcn_rcpf(1.0f + __builtin_amdgcn_exp2f(-x * LOG2E)); }
__device__ __forceinline__ float wave_sum(float v) {
#pragma unroll
    for (int o = 1; o < 64; o <<= 1) v += __shfl_xor(v, o);
    return v;
}
__device__ __forceinline__ float wave_max(float v) {
#pragma unroll
    for (int o = 1; o < 64; o <<= 1) v = fmaxf(v, __shfl_xor(v, o));
    return v;
}

#define XB_TMO      128
#define XB_XCNT(j)  (256  + 64 * (j))
#define XB_XSUB(j)  (1280 + 64 * (j))
#define XB_XGEN(j)  (2304 + 64 * (j))
#define XB_TOP      3328
#define XB_TOPGEN   3392
#define XCD_BAR_WORDS 3456
#define XB_SPIN_CAP (1u << 18)
__device__ __forceinline__ unsigned xb_ld(unsigned* p)              { return __hip_atomic_load(p, __ATOMIC_RELAXED, __HIP_MEMORY_SCOPE_AGENT); }
__device__ __forceinline__ unsigned xb_add(unsigned* p, unsigned v) { return __hip_atomic_fetch_add(p, v, __ATOMIC_RELAXED, __HIP_MEMORY_SCOPE_AGENT); }
__device__ __forceinline__ unsigned xb_xcc_id() { return (unsigned)__builtin_amdgcn_s_getreg((3 << 11) | 20) & 0xFu; }
#define XB_SPIN(cond, bar) do { unsigned _sp = 0; while (cond) { __builtin_amdgcn_s_sleep(1); \
    if ((++_sp & 255u) == 0u) { if (xb_ld(&(bar)[XB_TMO])) break; if (_sp > XB_SPIN_CAP) { atomicAdd(&(bar)[XB_TMO], 1u); break; } } } } while (0)
struct XcdBarrier { unsigned* bar; unsigned x; volatile LAS unsigned* st; };
__device__ __forceinline__ XcdBarrier xcd_barrier_post(unsigned* bar, volatile LAS unsigned* st) {
    XcdBarrier b; b.bar = bar; b.x = xb_xcc_id(); b.st = st;
    if (threadIdx.x == 0) (void)xb_add(&bar[XB_XCNT(b.x)], 1u);
    return b;
}
__device__ __forceinline__ void xcd_barrier_complete(unsigned* bar, unsigned x, unsigned& nloc, unsigned& nx) {
    const unsigned G = gridDim.x * gridDim.y * gridDim.z;
    unsigned sum, cnt, mine, sp = 0u;
    for (;;) {
        sum = 0u; cnt = 0u; mine = 0u;
#pragma unroll
        for (unsigned j = 0; j < 16; ++j) { const unsigned c = xb_ld(&bar[XB_XCNT(j)]); sum += c; cnt += (c > 0u) ? 1u : 0u; mine = (j == x) ? c : mine; }
        if (sum == G) break;
        __builtin_amdgcn_s_sleep(1);
        if ((++sp & 255u) == 0u) { if (xb_ld(&bar[XB_TMO])) break; if (sp > XB_SPIN_CAP) { atomicAdd(&bar[XB_TMO], 1u); break; } }
    }
    nloc = mine > 0u ? mine : 1u; nx = cnt > 0u ? cnt : 1u;
}
__device__ __forceinline__ void xcd_barrier(const XcdBarrier& b) {
    asm volatile("s_waitcnt vmcnt(0)" ::: "memory");
    __syncthreads();
    if (threadIdx.x == 0) {
        unsigned* bar = b.bar;
        __builtin_amdgcn_s_waitcnt(0);
        unsigned nloc = b.st[0], nx = b.st[1];
        if (nloc == 0u) { xcd_barrier_complete(bar, b.x, nloc, nx); b.st[0] = nloc; b.st[1] = nx; }
        const unsigned old = xb_add(&bar[XB_XSUB(b.x)], 1u);
        const unsigned gen = old / nloc;
        if (old + 1u == (gen + 1u) * nloc) {
            __builtin_amdgcn_fence(__ATOMIC_RELEASE, "agent");
            asm volatile("s_waitcnt vmcnt(0)" ::: "memory");
            const unsigned og = xb_add(&bar[XB_TOP], 1u);
            const unsigned tg = og / nx;
            if (og + 1u == (tg + 1u) * nx) xb_add(&bar[XB_TOPGEN], 1u);
            else XB_SPIN(xb_ld(&bar[XB_TOPGEN]) == tg, bar);
            __builtin_amdgcn_fence(__ATOMIC_ACQUIRE, "agent");
            xb_add(&bar[XB_XGEN(b.x)], 1u);
            asm volatile("s_waitcnt vmcnt(0)" ::: "memory");
        } else {
            XB_SPIN(xb_ld(&bar[XB_XGEN(b.x)]) == gen, bar);
            __builtin_amdgcn_fence(__ATOMIC_ACQUIRE, "agent");
            asm volatile("s_waitcnt vmcnt(0)" ::: "memory");
        }
    }
    __syncthreads();
}

constexpr int NWAVES = 8;
constexpr int RING_OFF = 0, RING_BYTES = 131072;
constexpr int LDSCTL_OFF = RING_BYTES, MISC_OFF = LDSCTL_OFF + 320;
constexpr int LDS_BYTES = 147456;

struct Frame {
    LAS unsigned char* lds;
    volatile LAS unsigned* MISC;
    gu32* ctl;
    int tid, lane, wave, vcu, G;
    const float *x, *mem, *norm_g, *mem_norm_g, *w_mem_kv, *w_out, *pool_w_in, *pool_w_group, *pool_scale, *mla_w_in, *mla_q_norm_g, *mla_w_uq, *mla_kv_norm_g, *mla_w_ukv, *final_norm_g;
    const int* positions;
    float* out;
    bf16_t *WIN0, *WMKV, *WOUT0, *WOUT1, *WIN1, *WUQ, *WUKV;
    bf16_t *XN, *MN, *MEMKV, *PROJ, *BR, *Q, *KN, *VV;
    float *CS, *ssq1, *ssq_q, *ssq_kv, *ssq2;
};

template <int MODE>
__device__ __forceinline__ int src_col(int n) {
    if (MODE == 1) { if (n >= L1_KR && n < L1_MQ) { const int j = n - L1_KR; return L1_KR + (j >> 1) + 32 * (j & 1); } return n; }
    if (MODE == 2) { const int h = n / 192, d = n - h * 192; if (d >= 128) { const int j = d - 128; return h * 192 + 128 + (j >> 1) + 32 * (j & 1); } return n; }
    return n;
}
__device__ __forceinline__ void transpose_writeout(LAS float* scr, bf16_t* WT, int K, int row0, int k0, int lane) {
    LDS_WAIT(); asm volatile("" ::: "memory");
    const int c = lane & 7;
#pragma unroll
    for (int j = 0; j < 4; ++j) { const int n = (lane >> 3) + 8 * j; const LAS float* s = scr + (8 * c) * 33 + n;
        u32x4 o; o.x = pk2(s[0 * 33], s[1 * 33]); o.y = pk2(s[2 * 33], s[3 * 33]); o.z = pk2(s[4 * 33], s[5 * 33]); o.w = pk2(s[6 * 33], s[7 * 33]);
        *(GAS u32x4*)(WT + (size_t)(row0 + n) * K + k0 + 8 * c) = o; }
    LDS_WAIT(); asm volatile("" ::: "memory");
}
template <int MODE>
__device__ __forceinline__ void p0_transpose_item(const float* W, int ldw, int col0, int nsrc, int K, int Ndst, const float* gain, bf16_t* WT, LAS float* scr, int item, int lane) {
    const int nblk = Ndst / 32, kb = item / nblk, nb = item % nblk, k0 = 64 * kb, n0 = 32 * nb;
    const int sc = src_col<MODE>(n0 + (lane & 31)); const bool ok = sc < nsrc;
#pragma unroll 8
    for (int i = 0; i < 32; ++i) { const int kk = 2 * i + (lane >> 5);
        float v = ok ? W[(size_t)(k0 + kk) * ldw + col0 + sc] : 0.f; if (gain) v *= gain[k0 + kk];
        scr[kk * 33 + (lane & 31)] = v; }
    transpose_writeout(scr, WT, K, n0, k0, lane);
}
__device__ __forceinline__ void p0_fold_item(const float* Win, const float* wg, const float* scale, bf16_t* WT, LAS float* scr, int item, int lane) {
    const int nblk = 768 / 32, kb = item / nblk, nb = item % nblk, k0 = 64 * kb, n0 = 32 * nb, g = n0 / 192, d = n0 - g * 192 + (lane & 31);
    const float* wgc = wg + (size_t)g * 192 * 192 + d;
    const float sc = scale[g * 192 + d];
    for (int ch = 0; ch < 3; ++ch) {
        float wv[64];
#pragma unroll
        for (int c = 0; c < 64; ++c) wv[c] = wgc[(size_t)(ch * 64 + c) * 192];
#pragma unroll 2
        for (int i = 0; i < 32; ++i) { const int kk = 2 * i + (lane >> 5);
            const f32x4* wr = (const f32x4*)(Win + (size_t)(k0 + kk) * 2048 + g * 192 + ch * 64);
            float a = 0.f;
#pragma unroll
            for (int c4 = 0; c4 < 16; ++c4) { const f32x4 w = wr[c4]; a += w.x * wv[4 * c4] + w.y * wv[4 * c4 + 1] + w.z * wv[4 * c4 + 2] + w.w * wv[4 * c4 + 3]; }
            LAS float* p = scr + kk * 33 + (lane & 31);
            if (ch == 0) *p = a; else if (ch == 1) *p += a; else *p = (*p + a) * sc; }
        LDS_WAIT(); asm volatile("" ::: "memory");
    }
    transpose_writeout(scr, WT, 1024, n0, k0, lane);
}
__device__ __forceinline__ void rms_row_to_bf16(const float* xrow, const float* g, bf16_t* orow, int lane) {
    const GAS f32x4* xr = (const GAS f32x4*)xrow + lane; const GAS f32x4* gr = (const GAS f32x4*)g + lane;
    f32x4 v[4]; float s = 0.f;
#pragma unroll
    for (int j = 0; j < 4; ++j) { v[j] = xr[64 * j]; s += (v[j].x * v[j].x + v[j].y * v[j].y) + (v[j].z * v[j].z + v[j].w * v[j].w); }
    const float rstd = 1.0f / sqrtf(wave_sum(s) * (1.f / 1024.f) + EPS);
    GAS unsigned long long* o8 = (GAS unsigned long long*)orow + lane;
#pragma unroll
    for (int j = 0; j < 4; ++j) { const f32x4 gg = gr[64 * j];
        o8[64 * j] = (unsigned long long)pk2(v[j].x * rstd * gg.x, v[j].y * rstd * gg.y) | ((unsigned long long)pk2(v[j].z * rstd * gg.z, v[j].w * rstd * gg.w) << 32); }
}
__device__ __forceinline__ void sincos_acc(float ang, float& c, float& s) {
    const double x = (double)ang;
    const double q = __builtin_rint(x * 0.63661977236758134308);
    double y = __builtin_fma(-q, 1.57079632679489655800e+00, x); y = __builtin_fma(-q, 6.12323399573676603587e-17, y);
    const double y2 = y * y;
    double sp = -1.0 / 1307674368000.0; sp = sp * y2 + 1.0 / 6227020800.0; sp = sp * y2 - 1.0 / 39916800.0; sp = sp * y2 + 1.0 / 362880.0; sp = sp * y2 - 1.0 / 5040.0; sp = sp * y2 + 1.0 / 120.0; sp = sp * y2 - 1.0 / 6.0; sp = sp * y2 * y + y;
    double cp = 1.0 / 20922789888000.0; cp = cp * y2 - 1.0 / 87178291200.0; cp = cp * y2 + 1.0 / 479001600.0; cp = cp * y2 - 1.0 / 3628800.0; cp = cp * y2 + 1.0 / 40320.0; cp = cp * y2 - 1.0 / 720.0; cp = cp * y2 + 1.0 / 24.0; cp = cp * y2 - 0.5; cp = cp * y2 + 1.0;
    const int n = (int)q & 3;
    const double ss = (n & 1) ? cp : sp, cc = (n & 1) ? sp : cp;
    s = (float)((n & 2) ? -ss : ss); c = (float)(((n + 1) & 2) ? -cc : cc);
}
__device__ __forceinline__ void p0_prologue(Frame& F) {
    LAS float* scr = (LAS float*)(F.lds + RING_OFF + F.wave * 16384);
    const int gw = F.vcu * NWAVES + F.wave, NGW = F.G * NWAVES;
    constexpr int I_FOLD = 16 * 24, I_IN0 = 16 * 40, I_MKV = 16 * 16, I_OUT = 16 * 32, I_IN1 = 16 * 64, I_UQ = 6 * 40, I_UKV = 4 * 48;
    constexpr int NITEMS = I_FOLD + I_IN0 + 2 * I_MKV + 2 * I_OUT + I_IN1 + I_UQ + I_UKV;
    for (int it = gw; it < NITEMS; it += NGW) {
        int r = it;
        if (r < I_FOLD) { p0_fold_item(F.pool_w_in, F.pool_w_group, F.pool_scale, F.WIN0, scr, r, F.lane); continue; } r -= I_FOLD;
        if (r < I_IN0) { p0_transpose_item<0>(F.pool_w_in, 2048, 768, 1280, 1024, 1280, nullptr, F.WIN0 + (size_t)768 * 1024, scr, r, F.lane); continue; } r -= I_IN0;
        if (r < I_MKV) { p0_transpose_item<0>(F.w_mem_kv, 512, 0, 512, 1024, 512, nullptr, F.WMKV, scr, r, F.lane); continue; } r -= I_MKV;
        if (r < I_MKV) { p0_transpose_item<0>(F.w_mem_kv + (size_t)1024 * 512, 512, 0, 512, 1024, 512, nullptr, F.WMKV + (size_t)512 * 1024, scr, r, F.lane); continue; } r -= I_MKV;
        if (r < I_OUT) { p0_transpose_item<0>(F.w_out, 1024, 0, 1024, 1024, 1024, nullptr, F.WOUT0, scr, r, F.lane); continue; } r -= I_OUT;
        if (r < I_OUT) { p0_transpose_item<0>(F.w_out + (size_t)1024 * 1024, 1024, 0, 1024, 1024, 1024, nullptr, F.WOUT1, scr, r, F.lane); continue; } r -= I_OUT;
        if (r < I_IN1) { p0_transpose_item<1>(F.mla_w_in, 1984, 0, 1984, 1024, 2048, F.norm_g + 1024, F.WIN1, scr, r, F.lane); continue; } r -= I_IN1;
        if (r < I_UQ) { p0_transpose_item<2>(F.mla_w_uq, 1152, 0, 1152, 384, 1280, F.mla_q_norm_g, F.WUQ, scr, r, F.lane); continue; } r -= I_UQ;
        p0_transpose_item<0>(F.mla_w_ukv, 1536, 0, 1536, 256, 1536, F.mla_kv_norm_g, F.WUKV, scr, r, F.lane);
    }
    for (int m = gw; m < M; m += NGW) rms_row_to_bf16(F.x + (size_t)m * DM, F.norm_g, F.XN + (size_t)m * DM, F.lane);
    for (int m = gw; m < MROWS; m += NGW) rms_row_to_bf16(F.mem + (size_t)m * DM, F.mem_norm_g, F.MN + (size_t)m * DM, F.lane);
    for (int e = F.vcu * NWAVES * 64 + F.tid; e < M * 32; e += F.G * NWAVES * 64) {
        const int tok = e >> 5, i = e & 31;
        const float inv = __builtin_amdgcn_exp2f(-(float)(2 * i) * (1.0f / 64.0f) * 13.287712379549449f);
        const float ang = (float)F.positions[tok] * inv;
        float c, s; sincos_acc(ang, c, s);
        *(GAS f32x2*)(F.CS + (size_t)e * 2) = (f32x2){c, s};
    }
}

struct EpiP1 {
    static constexpr bool PERM = true;
    bf16_t* proj; bf16_t* memkv;
    __device__ __forceinline__ void operator()(const f32x4 (&acc)[2][2][4][2], const pg8::Unit& u, int wr, int wc, int fr, int fq) const {
        const int row0 = u.pm * 256 + wr * 64 + fr, col0 = u.pn * 256 + wc * 32 + 8 * fq;
        bf16_t* base = u.g ? memkv : proj; const int ld = u.g ? 1024 : PLD;
        const int kind = u.g ? 0 : (u.pn < 3 ? 0 : (u.pn == 3 ? 1 : 2));
#pragma unroll
        for (int ai = 0; ai < 2; ++ai)
#pragma unroll
            for (int m = 0; m < 4; ++m) { bf16_t* rowp = base + (size_t)(row0 + ai * 128 + m * 16) * ld + col0;
#pragma unroll
                for (int bj = 0; bj < 2; ++bj) { f32x4 v0 = acc[ai][bj][m][0], v1 = acc[ai][bj][m][1];
                    if (kind == 1) { v0 = v0 * MQ_C2; v1 = v1 * MQ_C2; }
                    else if (kind == 2) {
#pragma unroll
                        for (int e = 0; e < 4; ++e) { v0[e] = silu_f(v0[e]); v1[e] = silu_f(v1[e]); } }
                    u32x4 w; w.x = cvt_pk_bf16(v0[0], v0[1]); w.y = cvt_pk_bf16(v0[2], v0[3]); w.z = cvt_pk_bf16(v1[0], v1[1]); w.w = cvt_pk_bf16(v1[2], v1[3]);
                    *(u32x4*)(rowp + bj * 128) = w; } }
    }
};
struct EpiOut {
    static constexpr bool PERM = false;
    const float* base; float* out; bf16_t* outb; float* ssq;
    __device__ __forceinline__ void operator()(const f32x4 (&acc)[2][2][4][2], const pg8::Unit& u, int wr, int wc, int fr, int fq) const {
        const int col0 = u.pn * 256 + wc * 32 + 4 * fq;
#pragma unroll
        for (int ai = 0; ai < 2; ++ai)
#pragma unroll
            for (int m = 0; m < 4; ++m) { const int row = u.pm * 256 + ai * 128 + wr * 64 + m * 16 + fr; const size_t off = (size_t)row * DM + col0; float s = 0.f;
#pragma unroll
                for (int bj = 0; bj < 2; ++bj)
#pragma unroll
                    for (int n = 0; n < 2; ++n) { const f32x4 h = *(const f32x4*)(base + off + bj * 128 + n * 16) + acc[ai][bj][m][n];
                        *(f32x4*)(out + off + bj * 128 + n * 16) = h; s += (h[0] * h[0] + h[1] * h[1]) + (h[2] * h[2] + h[3] * h[3]);
                        if (outb) { u32x2 w; w.x = cvt_pk_bf16(h[0], h[1]); w.y = cvt_pk_bf16(h[2], h[3]); *(u32x2*)(outb + off + bj * 128 + n * 16) = w; } }
                s += __shfl_xor(s, 16); s += __shfl_xor(s, 32);
                if (fq == 0) atomicAdd(ssq + row, s); }
    }
};
__device__ __forceinline__ f32x4 rope4(f32x4 v, f32x4 cs) { return (f32x4){v[0] * cs[0] - v[1] * cs[1], v[1] * cs[0] + v[0] * cs[1], v[2] * cs[2] - v[3] * cs[3], v[3] * cs[2] + v[2] * cs[3]}; }
struct EpiP4 {
    static constexpr bool PERM = true;
    bf16_t* proj; const float* ssq1; float* ssq_q; float* ssq_kv; const float* cs;
    __device__ __forceinline__ void operator()(const f32x4 (&acc)[2][2][4][2], const pg8::Unit& u, int wr, int wc, int fr, int fq) const {
        const int row0 = u.pm * 256 + wr * 64 + fr;
#pragma unroll
        for (int bj = 0; bj < 2; ++bj) {
            const int cw = u.pn * 256 + bj * 128 + wc * 32;
            const int kind = cw < L1_CKV ? 0 : cw < L1_KR ? 1 : cw < L1_MQ ? 2 : cw < L1_GATE ? 3 : cw < L1_END ? 4 : 5;
            if (kind == 5) continue;
            const int col0 = cw + 8 * fq;
#pragma unroll
            for (int ai = 0; ai < 2; ++ai)
#pragma unroll
                for (int m = 0; m < 4; ++m) { const int row = row0 + ai * 128 + m * 16;
                    const float r = 1.0f / sqrtf(ssq1[row] * (1.f / 1024.f) + EPS);
                    f32x4 v0 = acc[ai][bj][m][0] * r, v1 = acc[ai][bj][m][1] * r;
                    if (kind <= 1) { float s = (v0[0] * v0[0] + v0[1] * v0[1]) + (v0[2] * v0[2] + v0[3] * v0[3]) + (v1[0] * v1[0] + v1[1] * v1[1]) + (v1[2] * v1[2] + v1[3] * v1[3]);
                        s += __shfl_xor(s, 16); s += __shfl_xor(s, 32); if (fq == 0) atomicAdd((kind == 0 ? ssq_q : ssq_kv) + row, s); }
                    else if (kind == 2) { const int i0 = (col0 - L1_KR) >> 1; const f32x4* cp = (const f32x4*)(cs + ((size_t)row * 32 + i0) * 2); v0 = rope4(v0, cp[0]); v1 = rope4(v1, cp[1]); }
                    else if (kind == 3) { v0 = v0 * MQ_C2; v1 = v1 * MQ_C2; }
                    else {
#pragma unroll
                        for (int e = 0; e < 4; ++e) { v0[e] = silu_f(v0[e]); v1[e] = silu_f(v1[e]); } }
                    u32x4 w; w.x = cvt_pk_bf16(v0[0], v0[1]); w.y = cvt_pk_bf16(v0[2], v0[3]); w.z = cvt_pk_bf16(v1[0], v1[1]); w.w = cvt_pk_bf16(v1[2], v1[3]);
                    *(u32x4*)(proj + (size_t)row * PLD + col0) = w; asm volatile("" ::: "memory"); }
        }
    }
};
struct EpiQ {
    static constexpr bool PERM = true;
    bf16_t* q; const float* ssq_q; const float* cs;
    __device__ __forceinline__ void operator()(const f32x4 (&acc)[2][2][4][2], const pg8::Unit& u, int wr, int wc, int fr, int fq) const {
        const int row0 = u.pm * 256 + wr * 64 + fr;
#pragma unroll
        for (int bj = 0; bj < 2; ++bj) {
            const int col0 = u.pn * 256 + bj * 128 + wc * 32 + 8 * fq;
            if (u.pn * 256 + bj * 128 >= QLD) continue;
            const int d = col0 % 192; const bool rope = d >= 128; const int i0 = rope ? (d - 128) >> 1 : 0;
#pragma unroll
            for (int ai = 0; ai < 2; ++ai)
#pragma unroll
                for (int m = 0; m < 4; ++m) { const int row = row0 + ai * 128 + m * 16;
                    const float r = Q_C2 / sqrtf(ssq_q[row] * (1.f / 384.f) + EPS);
                    f32x4 v0 = acc[ai][bj][m][0] * r, v1 = acc[ai][bj][m][1] * r;
                    if (rope) { const f32x4* cp = (const f32x4*)(cs + ((size_t)row * 32 + i0) * 2); v0 = rope4(v0, cp[0]); v1 = rope4(v1, cp[1]); }
                    u32x4 w; w.x = cvt_pk_bf16(v0[0], v0[1]); w.y = cvt_pk_bf16(v0[2], v0[3]); w.z = cvt_pk_bf16(v1[0], v1[1]); w.w = cvt_pk_bf16(v1[2], v1[3]);
                    *(u32x4*)(q + (size_t)row * QLD + col0) = w; asm volatile("" ::: "memory"); }
        }
    }
};
struct EpiKV {
    static constexpr bool PERM = true;
    bf16_t* kn; bf16_t* vv; const float* ssq_kv;
    __device__ __forceinline__ void operator()(const f32x4 (&acc)[2][2][4][2], const pg8::Unit& u, int wr, int wc, int fr, int fq) const {
        const int row0 = u.pm * 256 + wr * 64 + fr, col0 = u.pn * 128 + wc * 32 + 8 * fq;
#pragma unroll
        for (int ai = 0; ai < 2; ++ai)
#pragma unroll
            for (int m = 0; m < 4; ++m) { const int row = row0 + ai * 128 + m * 16;
                const float r = 1.0f / sqrtf(ssq_kv[row] * (1.f / 256.f) + EPS);
#pragma unroll
                for (int bj = 0; bj < 2; ++bj) { const f32x4 v0 = acc[ai][bj][m][0] * r, v1 = acc[ai][bj][m][1] * r;
                    u32x4 w; w.x = cvt_pk_bf16(v0[0], v0[1]); w.y = cvt_pk_bf16(v0[2], v0[3]); w.z = cvt_pk_bf16(v1[0], v1[1]); w.w = cvt_pk_bf16(v1[2], v1[3]);
                    *(u32x4*)((bj ? vv : kn) + (size_t)row * KLD + col0) = w; } asm volatile("" ::: "memory"); }
    }
};

__device__ __forceinline__ void pool_phase(Frame& F) {
    const int gtid = F.vcu * NWAVES * 64 + F.tid, NT = F.G * NWAVES * 64;
    for (int e = gtid; e < M * 96; e += NT) {
        const int t = e / 96, cc = e - t * 96, c = cc * 8, g = c / 192, w = 2 << g, s = t & (SEQ - 1), cnt = (s + 1 < w) ? s + 1 : w;
        float sum[8];
#pragma unroll
        for (int k = 0; k < 8; ++k) sum[k] = 0.f;
        const bf16_t* zp = F.PROJ + (size_t)t * PLD + c;
        u32x4 z0 = *(const u32x4*)zp;
        for (int j = 0; j < cnt; ++j) { const u32x4 zz = *(const u32x4*)(zp - (size_t)j * PLD);
            sum[0] += bflo(zz.x); sum[1] += bfhi(zz.x); sum[2] += bflo(zz.y); sum[3] += bfhi(zz.y); sum[4] += bflo(zz.z); sum[5] += bfhi(zz.z); sum[6] += bflo(zz.w); sum[7] += bfhi(zz.w); }
        const float ic = 1.0f / (float)cnt;
        const u32x4 gg = *(const u32x4*)(F.PROJ + (size_t)t * PLD + L0_GATE + c);
        float o[8];
        o[0] = (sum[0] * ic - bflo(z0.x)) * bflo(gg.x); o[1] = (sum[1] * ic - bfhi(z0.x)) * bfhi(gg.x);
        o[2] = (sum[2] * ic - bflo(z0.y)) * bflo(gg.y); o[3] = (sum[3] * ic - bfhi(z0.y)) * bfhi(gg.y);
        o[4] = (sum[4] * ic - bflo(z0.z)) * bflo(gg.z); o[5] = (sum[5] * ic - bfhi(z0.z)) * bfhi(gg.z);
        o[6] = (sum[6] * ic - bflo(z0.w)) * bflo(gg.w); o[7] = (sum[7] * ic - bfhi(z0.w)) * bfhi(gg.w);
        u32x4 w4; w4.x = pk2(o[0], o[1]); w4.y = pk2(o[2], o[3]); w4.z = pk2(o[4], o[5]); w4.w = pk2(o[6], o[7]);
        *(u32x4*)(F.BR + (size_t)t * DM + c) = w4;
    }
}
__device__ __forceinline__ void memattn_naive(Frame& F, int layer, int mq_col, int gate_col) {
    const int gw = F.vcu * NWAVES + F.wave, NGW = F.G * NWAVES, lane = F.lane;
    for (int it = gw; it < M * 4; it += NGW) {
        const int t = it >> 2, h = it & 3, b = t / SEQ;
        const bf16_t* qp = F.PROJ + (size_t)t * PLD + mq_col + h * 64;
        float q[64];
#pragma unroll
        for (int c = 0; c < 8; ++c) { const u32x4 w = *(const u32x4*)(qp + 8 * c);
            q[8 * c] = bflo(w.x); q[8 * c + 1] = bfhi(w.x); q[8 * c + 2] = bflo(w.y); q[8 * c + 3] = bfhi(w.y); q[8 * c + 4] = bflo(w.z); q[8 * c + 5] = bfhi(w.z); q[8 * c + 6] = bflo(w.w); q[8 * c + 7] = bfhi(w.w); }
        const bf16_t* kb = F.MEMKV + (size_t)(b * NMEM) * 1024 + layer * 512 + h * 64;
        float sc[4];
#pragma unroll
        for (int j = 0; j < 4; ++j) { const bf16_t* kp = kb + (size_t)(j * 64 + lane) * 1024; float a = 0.f;
#pragma unroll
            for (int c = 0; c < 8; ++c) { const u32x4 w = *(const u32x4*)(kp + 8 * c);
                a += q[8 * c] * bflo(w.x) + q[8 * c + 1] * bfhi(w.x) + q[8 * c + 2] * bflo(w.y) + q[8 * c + 3] * bfhi(w.y) + q[8 * c + 4] * bflo(w.z) + q[8 * c + 5] * bfhi(w.z) + q[8 * c + 6] * bflo(w.w) + q[8 * c + 7] * bfhi(w.w); }
            sc[j] = a; }
        const float mx = wave_max(fmaxf(fmaxf(sc[0], sc[1]), fmaxf(sc[2], sc[3])));
        float p[4], ls = 0.f;
#pragma unroll
        for (int j = 0; j < 4; ++j) { p[j] = __builtin_amdgcn_exp2f(sc[j] - mx); ls += p[j]; }
        const float l = wave_sum(ls);
        const bf16_t* vb = kb + 256 + lane; float o = 0.f;
#pragma unroll
        for (int j = 0; j < 4; ++j)
            for (int s = 0; s < 64; ++s) { const float pp = __shfl(p[j], s); o += pp * bf2f(vb[(size_t)(j * 64 + s) * 1024]); }
        const float gt = bf2f(F.PROJ[(size_t)t * PLD + gate_col + 768 + h * 64 + lane]);
        F.BR[(size_t)t * DM + 768 + h * 64 + lane] = (bf16_t)f2bf(o / l * gt);
    }
}
__device__ __forceinline__ void mla_naive(Frame& F) {
    const int gw = F.vcu * NWAVES + F.wave, NGW = F.G * NWAVES, lane = F.lane, sub = lane & 7, kq = lane >> 3;
    LAS float* scs = (LAS float*)(F.lds + RING_OFF) + F.wave * 2048;
    for (int it = gw; it < M * 6; it += NGW) {
        const int h = it % 6, t = it / 6, b = t / SEQ, s = t & (SEQ - 1), nk = ((s >> 6) + 1) * 64;
        const bf16_t* qp = F.Q + (size_t)t * QLD + h * 192;
        float q[24];
        { const u32x4 w0 = *(const u32x4*)(qp + 8 * sub), w1 = *(const u32x4*)(qp + 64 + 8 * sub), w2 = *(const u32x4*)(qp + 128 + 8 * sub);
          q[0] = bflo(w0.x); q[1] = bfhi(w0.x); q[2] = bflo(w0.y); q[3] = bfhi(w0.y); q[4] = bflo(w0.z); q[5] = bfhi(w0.z); q[6] = bflo(w0.w); q[7] = bfhi(w0.w);
          q[8] = bflo(w1.x); q[9] = bfhi(w1.x); q[10] = bflo(w1.y); q[11] = bfhi(w1.y); q[12] = bflo(w1.z); q[13] = bfhi(w1.z); q[14] = bflo(w1.w); q[15] = bfhi(w1.w);
          q[16] = bflo(w2.x); q[17] = bfhi(w2.x); q[18] = bflo(w2.y); q[19] = bfhi(w2.y); q[20] = bflo(w2.z); q[21] = bfhi(w2.z); q[22] = bflo(w2.w); q[23] = bfhi(w2.w); }
        const size_t r0 = (size_t)b * SEQ;
        float mx = -3.0e38f;
        for (int kg = 0; kg < nk; kg += 8) { const int key = kg + kq;
            const bf16_t* kn = F.KN + (r0 + key) * KLD + h * 128 + 8 * sub; const bf16_t* kr = F.PROJ + (r0 + key) * PLD + L1_KR + 8 * sub;
            const u32x4 w0 = *(const u32x4*)kn, w1 = *(const u32x4*)(kn + 64), w2 = *(const u32x4*)kr;
            float a = q[0] * bflo(w0.x) + q[1] * bfhi(w0.x) + q[2] * bflo(w0.y) + q[3] * bfhi(w0.y) + q[4] * bflo(w0.z) + q[5] * bfhi(w0.z) + q[6] * bflo(w0.w) + q[7] * bfhi(w0.w);
            a += q[8] * bflo(w1.x) + q[9] * bfhi(w1.x) + q[10] * bflo(w1.y) + q[11] * bfhi(w1.y) + q[12] * bflo(w1.z) + q[13] * bfhi(w1.z) + q[14] * bflo(w1.w) + q[15] * bfhi(w1.w);
            a += q[16] * bflo(w2.x) + q[17] * bfhi(w2.x) + q[18] * bflo(w2.y) + q[19] * bfhi(w2.y) + q[20] * bflo(w2.z) + q[21] * bfhi(w2.z) + q[22] * bflo(w2.w) + q[23] * bfhi(w2.w);
            a += __shfl_xor(a, 1); a += __shfl_xor(a, 2); a += __shfl_xor(a, 4);
            mx = fmaxf(mx, a);
            if (sub == 0) scs[key] = a; }
        mx = wave_max(mx);
        LDS_WAIT(); asm volatile("" ::: "memory");
        float ls = 0.f;
        for (int k = lane; k < nk; k += 64) { const float p = __builtin_amdgcn_exp2f(scs[k] - mx); scs[k] = p; ls += p; }
        const float l = wave_sum(ls);
        LDS_WAIT(); asm volatile("" ::: "memory");
        const bf16_t* vp = F.VV + r0 * KLD + h * 128 + 2 * lane; float o0 = 0.f, o1 = 0.f;
        for (int k = 0; k < nk; ++k) { const float p = scs[k]; const unsigned w = *(const unsigned*)(vp + (size_t)k * KLD); o0 += p * bflo(w); o1 += p * bfhi(w); }
        const unsigned gw2 = *(const unsigned*)(F.PROJ + (size_t)t * PLD + L1_GATE + h * 128 + 2 * lane);
        const float il = 1.0f / l;
        *(unsigned*)(F.BR + (size_t)t * DM + h * 128 + 2 * lane) = pk2(o0 * il * bflo(gw2), o1 * il * bfhi(gw2));
        LDS_WAIT(); asm volatile("" ::: "memory");
    }
}
namespace fa {
typedef float f32x16 __attribute__((ext_vector_type(16)));
typedef short s16x4 __attribute__((ext_vector_type(4)));
constexpr float THR = 6.f;
__device__ __forceinline__ int crow(int r, int hi) { return (r & 3) + 8 * (r >> 2) + 4 * hi; }
struct Ptrs { const bf16_t* q; int ldq; const bf16_t* k1; int ldk1; const bf16_t* k2; int ldk2; const bf16_t* v; int ldv; const bf16_t* gate; int ldg; bf16_t* o; int ldo; };
template <int DQK, int DV> struct Geo {
    static constexpr int KROW = DQK * 2 + 16, KT = 64 * KROW, VT = 64 * DV * 2, BUF = KT + VT, NCB = DV / 32, ND0 = DQK / 16, WS_OFF = 2 * BUF, BYTES = WS_OFF + NWAVES * 256;
};
template <int NCB> __device__ __forceinline__ int v_st(int k, int c) { const int kk = (k & ~0xC) | ((k & 4) << 1) | ((k & 8) >> 1); return ((kk >> 3) * NCB + (c >> 5)) * 512 + ((kk & 7) * 32 + (c & 31)) * 2; }
__device__ __forceinline__ int v_rd_base(int lane) { return ((lane & 3) << 3) | (((lane >> 2) & 3) << 6) | (((lane >> 4) & 1) << 5) | (((lane >> 5) & 1) << 8); }

template <int DQK, int DK1, int DV, bool CAUSAL>
__device__ __forceinline__ void attn_block(LAS unsigned char* lds, const Ptrs P, const int NT, const int q0) {
    typedef Geo<DQK, DV> G;
    constexpr int KROW = G::KROW, KT = G::KT, BUF = G::BUF, NCB = G::NCB, ND0 = G::ND0;
    constexpr int NKC1 = DK1 / 8, NKC2 = (DQK - DK1) / 8, NVC = DV / 8;
    constexpr int NK1 = 64 * NKC1 / 512, NK2 = 64 * NKC2 / 512, NV = 64 * NVC / 512;
    static_assert(NK1 >= 1 && NV >= 1 && (NKC2 == 0 || NK2 == 1), "staging geometry");
    const int tid = threadIdx.x, wid = __builtin_amdgcn_readfirstlane(tid >> 6), lane = tid & 63, r32 = lane & 31, hi = lane >> 5;
    int k1row[NK1], k1ch[NK1], vkey[NV], vcc[NV];
#pragma unroll
    for (int i = 0; i < NK1; ++i) { const int id = tid + 512 * i; k1row[i] = id / NKC1; k1ch[i] = id % NKC1; }
#pragma unroll
    for (int i = 0; i < NV; ++i) { const int id = tid + 512 * i; vkey[i] = id / NVC; vcc[i] = id % NVC; }
    const int k2row = NKC2 ? tid / (NKC2 ? NKC2 : 1) : 0, k2ch = NKC2 ? tid % (NKC2 ? NKC2 : 1) : 0;
    bf16x8 sk1[NK1], sk2, sv[NV];
#define FA_SLOAD(t) do { const size_t kb_ = (size_t)(t) * 64; \
        _Pragma("unroll") for (int i = 0; i < NK1; ++i) sk1[i] = *(const bf16x8*)(P.k1 + (kb_ + k1row[i]) * P.ldk1 + k1ch[i] * 8); \
        if (NKC2) sk2 = *(const bf16x8*)(P.k2 + (kb_ + k2row) * P.ldk2 + k2ch * 8); \
        _Pragma("unroll") for (int i = 0; i < NV; ++i) sv[i] = *(const bf16x8*)(P.v + (kb_ + vkey[i]) * P.ldv + vcc[i] * 8); } while (0)
#define FA_SWRITE(bo) do { \
        _Pragma("unroll") for (int i = 0; i < NK1; ++i) *(LAS bf16x8*)(lds + (bo) + k1row[i] * KROW + k1ch[i] * 16) = sk1[i]; \
        if (NKC2) *(LAS bf16x8*)(lds + (bo) + k2row * KROW + (NKC1 + k2ch) * 16) = sk2; \
        _Pragma("unroll") for (int i = 0; i < NV; ++i) *(LAS bf16x8*)(lds + (bo) + KT + v_st<NCB>(vkey[i], vcc[i] * 8)) = sv[i]; } while (0)
    bf16x8 qr[ND0];
#pragma unroll
    for (int d0 = 0; d0 < ND0; ++d0) qr[d0] = *(const bf16x8*)(P.q + (size_t)(wid * 32 + r32) * P.ldq + d0 * 16 + hi * 8);
    LAS float* wsf = (LAS float*)(lds + G::WS_OFF) + wid * 64;
    float m_reg = -1e30f, l_reg = 0.f; f32x16 o[NCB];
#pragma unroll
    for (int d = 0; d < NCB; ++d) o[d] = f32x16{};
    const int lastt = CAUSAL ? ((q0 + wid * 32) >> 6) : NT - 1;
    const int vb0 = (int)(uintptr_t)(lds + KT) + v_rd_base(lane);
    FA_SLOAD(0); FA_SWRITE(0); __syncthreads();
    for (int t = 0; t < NT; ++t) {
        const int bo = (t & 1) * BUF;
        if (t + 1 < NT) FA_SLOAD(t + 1);
        if (t <= lastt) {
            f32x16 p0 = f32x16{}, p1 = f32x16{};
            const LAS unsigned char* kb = lds + bo + r32 * KROW + hi * 16;
#pragma unroll
            for (int d0 = 0; d0 < ND0; ++d0) { const bf16x8 b0 = *(const LAS bf16x8*)(kb + d0 * 32), b1 = *(const LAS bf16x8*)(kb + 32 * KROW + d0 * 32);
                p0 = __builtin_amdgcn_mfma_f32_32x32x16_bf16(b0, qr[d0], p0, 0, 0, 0); p1 = __builtin_amdgcn_mfma_f32_32x32x16_bf16(b1, qr[d0], p1, 0, 0, 0); }
            float pmax = p0[0];
#pragma unroll
            for (int r = 1; r < 16; ++r) pmax = fmaxf(pmax, p0[r]);
#pragma unroll
            for (int r = 0; r < 16; ++r) pmax = fmaxf(pmax, p1[r]);
            { auto rr = __builtin_amdgcn_permlane32_swap(__float_as_uint(pmax), __float_as_uint(pmax), false, false); pmax = fmaxf(__uint_as_float(rr[0]), __uint_as_float(rr[1])); }
            float alpha = 1.f;
            if (!__all(pmax - m_reg <= THR)) { const float mn = fmaxf(m_reg, pmax); alpha = __builtin_amdgcn_exp2f(m_reg - mn); m_reg = mn;
                if (hi == 0) wsf[r32] = alpha; LDS_WAIT();
#pragma unroll
                for (int d = 0; d < NCB; ++d)
#pragma unroll
                    for (int r = 0; r < 16; ++r) o[d][r] *= wsf[crow(r, hi)];
            }
            float ps = 0.f;
#pragma unroll
            for (int r = 0; r < 16; ++r) { p0[r] = __builtin_amdgcn_exp2f(p0[r] - m_reg); p1[r] = __builtin_amdgcn_exp2f(p1[r] - m_reg); ps += p0[r] + p1[r]; }
            { auto rr = __builtin_amdgcn_permlane32_swap(__float_as_uint(ps), __float_as_uint(ps), false, false); ps = __uint_as_float(rr[0]) + __uint_as_float(rr[1]); }
            l_reg = l_reg * alpha + ps;
            bf16x8 pa0, pa1, pa2, pa3;
#define FA_PK4(Pv, B_, OUT) do { unsigned a0 = cvt_pk_bf16(Pv[B_ + 0], Pv[B_ + 1]), a1 = cvt_pk_bf16(Pv[B_ + 2], Pv[B_ + 3]), b0_ = cvt_pk_bf16(Pv[B_ + 4], Pv[B_ + 5]), b1_ = cvt_pk_bf16(Pv[B_ + 6], Pv[B_ + 7]); \
        auto r0 = __builtin_amdgcn_permlane32_swap(a0, b0_, false, false); auto r1 = __builtin_amdgcn_permlane32_swap(a1, b1_, false, false); \
        u32x4 w_ = {r0[0], r1[0], r0[1], r1[1]}; OUT = __builtin_bit_cast(bf16x8, w_); } while (0)
            FA_PK4(p0, 0, pa0); FA_PK4(p0, 8, pa1); FA_PK4(p1, 0, pa2); FA_PK4(p1, 8, pa3);
#undef FA_PK4
#define FA_TRRD(dst, off) asm volatile("ds_read_b64_tr_b16 %0, %1 offset:%2" : "=&v"(dst) : "v"(vbt), "i"(off) : "memory")
            const int vbt = vb0 + bo;
#pragma unroll
            for (int d0 = 0; d0 < NCB; ++d0) { s16x4 l0, l1, l2, l3, h0, h1, h2, h3;
                FA_TRRD(l0, (0 * NCB + d0) * 512); FA_TRRD(h0, (1 * NCB + d0) * 512); FA_TRRD(l1, (2 * NCB + d0) * 512); FA_TRRD(h1, (3 * NCB + d0) * 512);
                FA_TRRD(l2, (4 * NCB + d0) * 512); FA_TRRD(h2, (5 * NCB + d0) * 512); FA_TRRD(l3, (6 * NCB + d0) * 512); FA_TRRD(h3, (7 * NCB + d0) * 512);
                asm volatile("s_waitcnt lgkmcnt(0)" ::: "memory"); __builtin_amdgcn_sched_barrier(0);
                o[d0] = __builtin_amdgcn_mfma_f32_32x32x16_bf16(pa0, (bf16x8){l0[0], l0[1], l0[2], l0[3], h0[0], h0[1], h0[2], h0[3]}, o[d0], 0, 0, 0);
                o[d0] = __builtin_amdgcn_mfma_f32_32x32x16_bf16(pa1, (bf16x8){l1[0], l1[1], l1[2], l1[3], h1[0], h1[1], h1[2], h1[3]}, o[d0], 0, 0, 0);
                o[d0] = __builtin_amdgcn_mfma_f32_32x32x16_bf16(pa2, (bf16x8){l2[0], l2[1], l2[2], l2[3], h2[0], h2[1], h2[2], h2[3]}, o[d0], 0, 0, 0);
                o[d0] = __builtin_amdgcn_mfma_f32_32x32x16_bf16(pa3, (bf16x8){l3[0], l3[1], l3[2], l3[3], h3[0], h3[1], h3[2], h3[3]}, o[d0], 0, 0, 0); }
#undef FA_TRRD
        }
        if (t + 1 < NT) FA_SWRITE(((t + 1) & 1) * BUF);
        __syncthreads();
    }
    if (hi == 0) wsf[32 + r32] = l_reg; LDS_WAIT();
    LAS bf16_t* stg = (LAS bf16_t*)(lds + wid * (32 * DV * 2));
#pragma unroll
    for (int r = 0; r < 16; ++r) { const float rl = __builtin_amdgcn_rcpf(wsf[32 + crow(r, hi)]); const int orow = crow(r, hi);
#pragma unroll
        for (int d0 = 0; d0 < NCB; ++d0) stg[orow * DV + d0 * 32 + r32] = (bf16_t)f2bf(o[d0][r] * rl); }
    LDS_WAIT(); asm volatile("" ::: "memory");
    constexpr int RPP = 64 / NVC;
#pragma unroll
    for (int i = 0; i < 32 / RPP; ++i) { const int row = i * RPP + lane / NVC, ch = lane % NVC;
        const u32x4 ov = *(const LAS u32x4*)(stg + row * DV + ch * 8);
        const u32x4 gv = *(const u32x4*)(P.gate + (size_t)(wid * 32 + row) * P.ldg + ch * 8);
        u32x4 w; w.x = pk2(bflo(ov.x) * bflo(gv.x), bfhi(ov.x) * bfhi(gv.x)); w.y = pk2(bflo(ov.y) * bflo(gv.y), bfhi(ov.y) * bfhi(gv.y));
        w.z = pk2(bflo(ov.z) * bflo(gv.z), bfhi(ov.z) * bfhi(gv.z)); w.w = pk2(bflo(ov.w) * bflo(gv.w), bfhi(ov.w) * bfhi(gv.w));
        *(u32x4*)(P.o + (size_t)(wid * 32 + row) * P.ldo + ch * 8) = w; }
    __syncthreads();
#undef FA_SLOAD
#undef FA_SWRITE
}
}
__device__ __forceinline__ void mla_phase(Frame& F, gu32* head) {
    volatile LAS unsigned* slot = F.MISC + 16;
    for (;;) {
        if (F.tid == 0) slot[0] = __hip_atomic_fetch_add(head, 1u, RLX_AGENT);
        __syncthreads();
        const int I = (int)slot[0];
        __syncthreads();
        if (I >= 96 * 8) break;
        const int qb = 7 - I / 96, bh = I % 96, b = bh / 6, h = bh % 6;
        const size_t r0 = (size_t)b * SEQ, rq = r0 + qb * 256;
        fa::Ptrs P{F.Q + rq * QLD + h * 192, QLD, F.KN + r0 * KLD + h * 128, KLD, F.PROJ + r0 * PLD + L1_KR, PLD, F.VV + r0 * KLD + h * 128, KLD,
                   F.PROJ + rq * PLD + L1_GATE + h * 128, PLD, F.BR + rq * DM + h * 128, DM};
        fa::attn_block<192, 128, 128, true>(F.lds + RING_OFF, P, 4 * qb + 4, qb * 256);
    }
}
__device__ __forceinline__ void memattn_phase(Frame& F, int layer, int mq_col, int gate_col) {
    for (int u = F.vcu; u < 16 * 8 * 4; u += F.G) {
        const int h = u & 3, tb = u >> 2; const size_t rq = (size_t)tb * 256, b = rq / SEQ;
        const bf16_t* kv = F.MEMKV + (size_t)(b * NMEM) * 1024 + layer * 512 + h * 64;
        fa::Ptrs P{F.PROJ + rq * PLD + mq_col + h * 64, PLD, kv, 1024, nullptr, 0, kv + 256, 1024,
                   F.PROJ + rq * PLD + gate_col + 768 + h * 64, PLD, F.BR + rq * DM + 768 + h * 64, DM};
        fa::attn_block<64, 64, 64, false>(F.lds + RING_OFF, P, 4, 0);
    }
}
__device__ __forceinline__ void final_norm(Frame& F) {
    const int gw = F.vcu * NWAVES + F.wave, NGW = F.G * NWAVES;
    for (int m = gw; m < M; m += NGW) {
        const float r = 1.0f / sqrtf(F.ssq2[m] * (1.f / 1024.f) + EPS);
        GAS f32x4* o = (GAS f32x4*)(F.out + (size_t)m * DM) + F.lane; const GAS f32x4* g = (const GAS f32x4*)F.final_norm_g + F.lane;
#pragma unroll
        for (int j = 0; j < 4; ++j) { const f32x4 v = o[64 * j], gg = g[64 * j]; o[64 * j] = (f32x4){v.x * r * gg.x, v.y * r * gg.y, v.z * r * gg.z, v.w * r * gg.w}; }
    }
}

struct Args { const void* in[16]; float* out; unsigned char* ws; int ph_lo, ph_hi; };
constexpr int N_PHASES = 9;
__global__ void __launch_bounds__(NWAVES * 64, 2) trunk_fwd(Args args) {
    extern __shared__ __attribute__((aligned(16))) unsigned char lds[];
    Frame F;
    F.lds = (LAS unsigned char*)lds;
    F.MISC = (volatile LAS unsigned*)(F.lds + MISC_OFF);
    F.tid = threadIdx.x; F.lane = F.tid & 63; F.wave = __builtin_amdgcn_readfirstlane(F.tid >> 6);
    F.G = gridDim.x; { const int bx = blockIdx.x; F.vcu = (F.G % 8 == 0) ? (bx % 8) * (F.G / 8) + bx / 8 : bx; }
    unsigned char* ws = args.ws;
    F.ctl = (gu32*)(ws + WS_CTL);
    F.x = (const float*)args.in[0]; F.mem = (const float*)args.in[1]; F.positions = (const int*)args.in[2]; F.norm_g = (const float*)args.in[3]; F.mem_norm_g = (const float*)args.in[4];
    F.w_mem_kv = (const float*)args.in[5]; F.w_out = (const float*)args.in[6]; F.pool_w_in = (const float*)args.in[7]; F.pool_w_group = (const float*)args.in[8]; F.pool_scale = (const float*)args.in[9];
    F.mla_w_in = (const float*)args.in[10]; F.mla_q_norm_g = (const float*)args.in[11]; F.mla_w_uq = (const float*)args.in[12]; F.mla_kv_norm_g = (const float*)args.in[13]; F.mla_w_ukv = (const float*)args.in[14];
    F.final_norm_g = (const float*)args.in[15]; F.out = args.out;
    F.WIN0 = (bf16_t*)(ws + WS_WIN0); F.WMKV = (bf16_t*)(ws + WS_WMKV); F.WOUT0 = (bf16_t*)(ws + WS_WOUT0); F.WOUT1 = (bf16_t*)(ws + WS_WOUT1); F.WIN1 = (bf16_t*)(ws + WS_WIN1);
    F.WUQ = (bf16_t*)(ws + WS_WUQ); F.WUKV = (bf16_t*)(ws + WS_WUKV);
    F.XN = (bf16_t*)(ws + WS_XN); F.MN = (bf16_t*)(ws + WS_MN); F.MEMKV = (bf16_t*)(ws + WS_MEMKV); F.PROJ = (bf16_t*)(ws + WS_PROJ); F.BR = (bf16_t*)(ws + WS_BR);
    F.Q = (bf16_t*)(ws + WS_Q); F.KN = (bf16_t*)(ws + WS_KN); F.VV = (bf16_t*)(ws + WS_VV);
    F.CS = (float*)(ws + WS_CS); F.ssq1 = (float*)(ws + WS_SSQ); F.ssq_q = F.ssq1 + M; F.ssq_kv = F.ssq_q + M; F.ssq2 = F.ssq_kv + M;
    for (int u = F.tid; u < (LDS_BYTES - LDSCTL_OFF) / 4; u += NWAVES * 64) ((LAS unsigned*)(F.lds + LDSCTL_OFF))[u] = 0u;
    __syncthreads();
    const int lo = args.ph_lo, hi = args.ph_hi;
    XcdBarrier bar; bar.bar = (unsigned*)(F.ctl + CW_BAR); bar.x = 0; bar.st = nullptr;
    if (hi - lo > 1) bar = xcd_barrier_post((unsigned*)(F.ctl + CW_BAR), F.MISC + 8);
#ifndef PHASE_MASK
#define PHASE_MASK 0x1ff
#endif
#define IN(k) (((PHASE_MASK >> (k)) & 1) && lo <= (k) && (k) < hi)
#define SEAM(k) do { if (IN(k) && IN((k) + 1)) xcd_barrier(bar); } while (0)
    const int bx = (int)blockIdx.x;
    if (IN(0)) { p0_prologue(F); SEAM(0); }
    if (IN(1)) {
        pg8::Sched2 S{F.XN, F.WIN0, F.MN, F.WMKV, M, 2048, MROWS, 1024, 1024, 1024, F.G, bx};
        EpiP1 E{F.PROJ, F.MEMKV};
        pg8::gemm_phase(F.lds + RING_OFF, 1024, 1024, 1024, S, E);
        SEAM(1);
    }
    if (IN(2)) { pool_phase(F);
#if defined(MEMATTN_NAIVE)
        memattn_naive(F, 0, L0_MQ, L0_GATE);
#else
        memattn_phase(F, 0, L0_MQ, L0_GATE);
#endif
        SEAM(2); }
    if (IN(3)) {
        pg8::Sched1 S{F.BR, F.WOUT0, M, 1024, 1024, 1024, F.G, bx};
        EpiOut E{F.x, F.out, F.XN, F.ssq1};
        pg8::gemm_phase(F.lds + RING_OFF, 1024, 1024, 1024, S, E);
        SEAM(3);
    }
    if (IN(4)) {
        pg8::Sched1 S{F.XN, F.WIN1, M, 2048, 1024, 1024, F.G, bx};
        EpiP4 E{F.PROJ, F.ssq1, F.ssq_q, F.ssq_kv, F.CS};
        pg8::gemm_phase(F.lds + RING_OFF, 1024, 1024, 1024, S, E);
        SEAM(4);
    }
    if (IN(5)) {
        { pg8::Sched1 S{F.PROJ, F.WUQ, M, 1280, PLD, 384, F.G, bx}; EpiQ E{F.Q, F.ssq_q, F.CS};
          pg8::gemm_phase(F.lds + RING_OFF, 384, PLD, 384, S, E); }
        { pg8::Sched1 S{F.PROJ + L1_CKV, F.WUKV, M, 1536, PLD, 256, F.G, bx}; EpiKV E{F.KN, F.VV, F.ssq_kv};
          pg8::gemm_phase(F.lds + RING_OFF, 256, PLD, 256, S, E); }
        SEAM(5);
    }
    if (IN(6)) {
#if defined(MLA_NAIVE)
        mla_naive(F);
#else
        mla_phase(F, F.ctl + CW_QHEAD);
#endif
#if defined(MEMATTN_NAIVE)
        memattn_naive(F, 1, L1_MQ, L1_GATE);
#else
        memattn_phase(F, 1, L1_MQ, L1_GATE);
#endif
        SEAM(6); }
    if (IN(7)) {
        pg8::Sched1 S{F.BR, F.WOUT1, M, 1024, 1024, 1024, F.G, bx};
        EpiOut E{F.out, F.out, nullptr, F.ssq2};
        pg8::gemm_phase(F.lds + RING_OFF, 1024, 1024, 1024, S, E);
        SEAM(7);
    }
    if (IN(8)) { final_norm(F); }
#undef IN
#undef SEAM
}

extern "C" void kernel_launch(void* const* d_in, const int* in_sizes, int n_in, void* d_out, int out_size, void* d_ws, size_t ws_size, hipStream_t stream) {
    static int grid = 0;
    if (grid == 0) {
        if (n_in != 16 || in_sizes[0] != M * DM || out_size != M * DM || ws_size < WS_END) { fprintf(stderr, "kernel_launch: unexpected shapes (n_in %d, in0 %d, out %d, ws %zu); nothing launched\n", n_in, n_in > 0 ? in_sizes[0] : -1, out_size, ws_size); grid = -1; return; }
        int dev = 0, cus = 0, per_cu = 0;
        if (hipGetDevice(&dev) != hipSuccess || hipDeviceGetAttribute(&cus, hipDeviceAttributeMultiprocessorCount, dev) != hipSuccess) { grid = -1; return; }
        if (hipFuncSetAttribute((const void*)trunk_fwd, hipFuncAttributeMaxDynamicSharedMemorySize, LDS_BYTES) != hipSuccess) { fprintf(stderr, "kernel_launch: hipFuncSetAttribute failed\n"); grid = -1; return; }
        if (hipOccupancyMaxActiveBlocksPerMultiprocessor(&per_cu, (const void*)trunk_fwd, NWAVES * 64, LDS_BYTES) != hipSuccess || per_cu < 1) { fprintf(stderr, "kernel_launch: occupancy query says %d blocks per CU; nothing launched\n", per_cu); (void)hipGetLastError(); grid = -1; return; }
        grid = cus;
    }
    if (grid < 0) return;
    (void)hipMemsetAsync((char*)d_ws + WS_CTL, 0, CTL_ZERO_BYTES, stream);
    Args a{};
    for (int i = 0; i < 16; ++i) a.in[i] = d_in[i];
    a.out = (float*)d_out; a.ws = (unsigned char*)d_ws;
    if (MK_N_LAUNCHES == 1) { a.ph_lo = 0; a.ph_hi = N_PHASES; hipLaunchKernelGGL(trunk_fwd, dim3(grid), dim3(NWAVES * 64), LDS_BYTES, stream, a); }
    else for (int p = 0; p < N_PHASES; ++p) { a.ph_lo = p; a.ph_hi = p + 1; hipLaunchKernelGGL(trunk_fwd, dim3(grid), dim3(NWAVES * 64), LDS_BYTES, stream, a); }
}
```

```cpp
#include <hip/hip_runtime.h>
#include <cstdio>
#include <cstdint>

#ifndef MK_N_LAUNCHES
#define MK_N_LAUNCHES 1
#endif

#define LAS __attribute__((address_space(3)))
#define GAS __attribute__((address_space(1)))
typedef unsigned short bf16_t;
typedef short bf16x8 __attribute__((ext_vector_type(8)));
typedef float f32x4 __attribute__((ext_vector_type(4)));
typedef float f32x2 __attribute__((ext_vector_type(2)));
typedef unsigned u32x4 __attribute__((ext_vector_type(4)));
typedef unsigned u32x2 __attribute__((ext_vector_type(2)));
typedef GAS unsigned gu32;

constexpr int BATCH = 16, SEQ = 2048, DM = 1024, M = BATCH * SEQ;
constexpr int NMEM = 256, MROWS = BATCH * NMEM;
constexpr int PLD = 2048;
constexpr int L0_MQ = 768, L0_GATE = 1024;
constexpr int L1_CKV = 384, L1_KR = 640, L1_MQ = 704, L1_GATE = 960, L1_END = 1984;
constexpr int QLD = 1152, KLD = 768;
constexpr float EPS = 1e-6f, LOG2E = 1.4426950408889634f;
constexpr float MQ_C2 = 0.125f * LOG2E;
constexpr float Q_C2 = 0.07216878364870323f * LOG2E;

constexpr size_t MiB = 1u << 20;
constexpr size_t WS_CTL = 0, CTL_ZERO_BYTES = 2 * MiB;
constexpr size_t WS_SSQ = 1 * MiB;
constexpr size_t WS_WIN0 = 2 * MiB, WS_WMKV = 6 * MiB, WS_WOUT0 = 8 * MiB, WS_WOUT1 = 10 * MiB, WS_WIN1 = 12 * MiB, WS_WUQ = 16 * MiB, WS_WUKV = 17 * MiB;
constexpr size_t WS_CS = 18 * MiB, WS_MN = 26 * MiB, WS_MEMKV = 34 * MiB;
constexpr size_t WS_XN = 48 * MiB;
constexpr size_t WS_PROJ = 112 * MiB, WS_BR = 240 * MiB, WS_Q = 304 * MiB, WS_KN = 376 * MiB, WS_VV = 424 * MiB, WS_END = 472 * MiB;
constexpr int CW_BAR = 4096, CW_QHEAD = 64;

__device__ __forceinline__ int lane_id();
namespace pg8 {
constexpr int BM = 256, BK = 64, HALF = 128, HTB = HALF * BK * 2, STAGE_BYTES = 8 * HTB, NXCD = 8, WGM = 8;
__host__ __device__ __forceinline__ int lds_byte(int r, int c) { const int st = (r >> 4) * 2 + (c >> 5), rr = r & 15, cc = c & 31, ob = rr * 64 + cc * 2; return st * 1024 + (ob ^ (((ob >> 9) & 1) << 5)); }
__host__ __device__ __forceinline__ void stage_rc(int b, int& R, int& C) { const int st = b / 1024, sb = b % 1024, swz = sb ^ (((sb >> 9) & 1) << 5); R = (st >> 1) * 16 + swz / 64; C = (st & 1) * 32 + (swz % 64) / 2; }
__host__ __device__ __forceinline__ int perm32(int rho) { const int n = rho >> 4, i = rho & 15; return 8 * (i >> 2) + 4 * n + (i & 3); }

struct Unit { int pm, pn, g; };
__device__ __forceinline__ int static_unit(int M_, int N_, int L) {
    const int nM = M_ / BM, nN = N_ / BM, nwg = nM * nN;
    int wgid = L; { const int q = nwg / NXCD, r = nwg % NXCD, xcd = wgid % NXCD, off = wgid / NXCD; wgid = (xcd < r ? xcd * (q + 1) : r * (q + 1) + (xcd - r) * q) + off; }
    const int nig = WGM * nN, gid = wgid / nig, fm = gid * WGM, gsz = (nM - fm) < WGM ? (nM - fm) : WGM;
    return ((fm + ((wgid % nig) % gsz)) << 16) | ((wgid % nig) / gsz);
}
struct Sched1 {
    const bf16_t* A; const bf16_t* Bt; int M_, N_, lda, ldb, G, c;
    __device__ __forceinline__ Unit next(int i, bool& ok) const { const int L = i * G + c; ok = L < (M_ / BM) * (N_ / BM); const int p = static_unit(M_, N_, ok ? L : 0); return Unit{p >> 16, p & 0xffff, 0}; }
    __device__ __forceinline__ const char* aptr(const Unit& u) const { return (const char*)(A + (size_t)u.pm * BM * lda); }
    __device__ __forceinline__ const char* bptr(const Unit& u) const { return (const char*)(Bt + (size_t)u.pn * BM * ldb); }
};
struct Sched2 {
    const bf16_t* A0; const bf16_t* B0; const bf16_t* A1; const bf16_t* B1; int M0, N0, M1, N1, lda, ldb, G, c;
    __device__ __forceinline__ Unit next(int i, bool& ok) const {
        const int n0 = (M0 / BM) * (N0 / BM), n1 = (M1 / BM) * (N1 / BM), L = i * G + c; ok = L < n0 + n1;
        const int p = static_unit(M0, N0, L < n0 ? L : 0), r = L - n0, g = L >= n0 ? 1 : 0;
        return Unit{g ? r / (N1 / BM) : (p >> 16), g ? r % (N1 / BM) : (p & 0xffff), g};
    }
    __device__ __forceinline__ const char* aptr(const Unit& u) const { return (const char*)((u.g ? A1 : A0) + (size_t)u.pm * BM * lda); }
    __device__ __forceinline__ const char* bptr(const Unit& u) const { return (const char*)((u.g ? B1 : B0) + (size_t)u.pn * BM * ldb); }
};

template <class Epi, class Sched>
__device__ __forceinline__ void gemm_phase(LAS unsigned char* lds, const int wid, const int K, const int lda, const int ldb, const Sched& S, const Epi& E) {
    const int lane = lane_id(), tid = wid * 64 + lane, wr = wid >> 2, wc = wid & 3, fr = lane & 15, fq = lane >> 4;
    const int nt = K / BK;
    unsigned voffA[2], voffB[2];
#pragma unroll
    for (int i = 0; i < 2; ++i) { int R, C; stage_rc(tid * 16 + i * 8192, R, C); const int Rb = Epi::PERM ? ((R & ~31) + perm32(R & 31)) : R;
        voffA[i] = (unsigned)(R * lda + C) * 2u; voffB[i] = (unsigned)(Rb * ldb + C) * 2u; }
    const size_t kstep = (size_t)(BK * 2);
    const size_t hstepA = (size_t)HALF * lda * 2, hstepB = (size_t)HALF * ldb * 2;
    const unsigned ldsw = (unsigned)wid * 1024u;
    const int aoff = lds_byte(wr * 64 + fr, fq * 8), boff = lds_byte(wc * 32 + fr, fq * 8);
#define PG8_SA(b, h) (((b) * 2 + (h)) * HTB)
#define PG8_SB(b, h) ((4 + (b) * 2 + (h)) * HTB)
#define PG8_STAGE(bufoff, gbase, voff) do { _Pragma("unroll") for (int _i = 0; _i < 2; ++_i) \
        __builtin_amdgcn_global_load_lds((const unsigned*)((const char*)(gbase) + (voff)[_i]), (LAS unsigned*)(lds + (bufoff) + ldsw + _i * 8192), 16, 0, 0); } while (0)
#define PG8_LDA(dst, b, h) do { _Pragma("unroll") for (int m = 0; m < 4; ++m) _Pragma("unroll") for (int k = 0; k < 2; ++k) dst[m][k] = *(const LAS bf16x8*)(lds + PG8_SA(b, h) + aoff + m * 2048 + k * 1024); } while (0)
#define PG8_LDB(dst, b, h) do { _Pragma("unroll") for (int n = 0; n < 2; ++n) _Pragma("unroll") for (int k = 0; k < 2; ++k) dst[n][k] = *(const LAS bf16x8*)(lds + PG8_SB(b, h) + boff + n * 2048 + k * 1024); } while (0)
#define PG8_MMA(ai, bj, At, Bt) do { __builtin_amdgcn_s_setprio(1); _Pragma("unroll") for (int m = 0; m < 4; ++m) _Pragma("unroll") for (int n = 0; n < 2; ++n) _Pragma("unroll") for (int k = 0; k < 2; ++k) \
        acc[ai][bj][m][n] = __builtin_amdgcn_mfma_f32_16x16x32_bf16(Bt[n][k], At[m][k], acc[ai][bj][m][n], 0, 0, 0); __builtin_amdgcn_s_setprio(0); } while (0)
#define PG8_WAIT_V(n) asm volatile("s_waitcnt vmcnt(" #n ")" ::: "memory")
#define PG8_WAIT_L(n) asm volatile("s_waitcnt lgkmcnt(" #n ")" ::: "memory")
#define PG8_BAR __builtin_amdgcn_s_barrier()
#define PG8_SCHED __builtin_amdgcn_sched_barrier(0)
    int ui = 0; bool ok0;
    Unit cur = S.next(0, ok0);
    if (!ok0) return;
    f32x4 acc[2][2][4][2];
#pragma unroll
    for (int a = 0; a < 2; ++a)
#pragma unroll
        for (int b = 0; b < 2; ++b)
#pragma unroll
            for (int m = 0; m < 4; ++m)
#pragma unroll
                for (int n = 0; n < 2; ++n) acc[a][b][m][n] = (f32x4){0.f, 0.f, 0.f, 0.f};
    bf16x8 At[4][2], B0[2][2], B1[2][2];
    const char* cA = S.aptr(cur); const char* cB = S.bptr(cur);
    PG8_STAGE(PG8_SB(0, 0), cB, voffB); PG8_STAGE(PG8_SB(0, 1), cB + hstepB, voffB); PG8_STAGE(PG8_SA(0, 0), cA, voffA); PG8_STAGE(PG8_SA(0, 1), cA + hstepA, voffA);
    if (wr == 1) PG8_BAR;
    PG8_WAIT_V(2); PG8_BAR;
    PG8_STAGE(PG8_SB(1, 0), cB + kstep, voffB); PG8_STAGE(PG8_SA(1, 0), cA + kstep, voffA); PG8_STAGE(PG8_SB(1, 1), cB + hstepB + kstep, voffB);
    PG8_WAIT_V(6); PG8_BAR;
    for (;;) {
        bool has_next; const Unit nxt = S.next(ui + 1, has_next);
        const char* nA = has_next ? S.aptr(nxt) : cA; const char* nB = has_next ? S.bptr(nxt) : cB;
#pragma unroll 1
        for (int t = 0; t < nt; t += 2) {
            const bool last = (t == nt - 2);
            const char* a1 = cA + (size_t)(t + 1) * kstep;
            const char* a2 = last ? nA : cA + (size_t)(t + 2) * kstep; const char* b2 = last ? nB : cB + (size_t)(t + 2) * kstep;
            const char* a3 = a2 + kstep; const char* b3 = b2 + kstep;
            PG8_LDB(B0, 0, 0); PG8_LDB(B1, 0, 1); PG8_SCHED; PG8_LDA(At, 0, 0); PG8_STAGE(PG8_SA(1, 1), a1 + hstepA, voffA);
            PG8_WAIT_V(8); PG8_WAIT_L(0); PG8_BAR; PG8_MMA(0, 0, At, B0); PG8_MMA(0, 1, At, B1); PG8_BAR; PG8_SCHED;
            PG8_LDA(At, 0, 1); PG8_STAGE(PG8_SB(0, 0), b2, voffB); PG8_STAGE(PG8_SB(0, 1), b2 + hstepB, voffB); PG8_STAGE(PG8_SA(0, 0), a2, voffA);
            PG8_WAIT_V(8); PG8_WAIT_L(0); PG8_BAR; PG8_MMA(1, 0, At, B0); PG8_MMA(1, 1, At, B1); PG8_BAR; PG8_SCHED;
            PG8_LDB(B0, 1, 0); PG8_LDB(B1, 1, 1); PG8_SCHED; PG8_LDA(At, 1, 0); PG8_STAGE(PG8_SA(0, 1), a2 + hstepA, voffA);
            PG8_WAIT_V(8); PG8_WAIT_L(0); PG8_BAR; PG8_MMA(0, 0, At, B0); PG8_MMA(0, 1, At, B1); PG8_BAR; PG8_SCHED;
            PG8_LDA(At, 1, 1); PG8_STAGE(PG8_SB(1, 0), b3, voffB); PG8_STAGE(PG8_SB(1, 1), b3 + hstepB, voffB); PG8_STAGE(PG8_SA(1, 0), a3, voffA);
            PG8_WAIT_V(8); PG8_WAIT_L(0); PG8_BAR; PG8_MMA(1, 0, At, B0); PG8_MMA(1, 1, At, B1); PG8_BAR; PG8_SCHED;
        }
        if (wr == 0) PG8_BAR;
        E(acc, cur, wr, wc, fr, fq);
        if (!has_next) break;
#pragma unroll
        for (int a = 0; a < 2; ++a)
#pragma unroll
            for (int b = 0; b < 2; ++b)
#pragma unroll
                for (int m = 0; m < 4; ++m)
#pragma unroll
                    for (int n = 0; n < 2; ++n) acc[a][b][m][n] = (f32x4){0.f, 0.f, 0.f, 0.f};
        cur = nxt; cA = nA; cB = nB; ++ui;
        if (wr == 1) PG8_BAR;
    }
    PG8_WAIT_V(0);
    PG8_BAR;
#undef PG8_SA
#undef PG8_SB
#undef PG8_STAGE
#undef PG8_LDA
#undef PG8_LDB
#undef PG8_MMA
#undef PG8_WAIT_V
#undef PG8_WAIT_L
#undef PG8_BAR
#undef PG8_SCHED
}
}

__device__ __forceinline__ int lane_id() { int l; asm volatile("v_mbcnt_lo_u32_b32 %0, -1, 0\n\tv_mbcnt_hi_u32_b32 %0, -1, %0" : "=v"(l)); return l; }
#define RLX_AGENT __ATOMIC_RELAXED, __HIP_MEMORY_SCOPE_AGENT
#define LDS_WAIT() asm volatile("s_waitcnt lgkmcnt(0)" ::: "memory")
#define VM_WAIT() asm volatile("s_waitcnt vmcnt(0)" ::: "memory")
__device__ __forceinline__ unsigned f2bf(float f) { unsigned u = __builtin_bit_cast(unsigned, f); return (u + 0x7fffu + ((u >> 16) & 1u)) >> 16; }
__device__ __forceinline__ unsigned pk2(float lo, float hi) { return f2bf(lo) | (f2bf(hi) << 16); }
__device__ __forceinline__ float bf2f(unsigned short b) { return __builtin_bit_cast(float, (unsigned)b << 16); }
__device__ __forceinline__ float bflo(unsigned w) { return __builtin_bit_cast(float, w << 16); }
__device__ __forceinline__ float bfhi(unsigned w) { return __builtin_bit_cast(float, w & 0xffff0000u); }
__device__ __forceinline__ unsigned cvt_pk_bf16(float lo, float hi) { unsigned r; asm volatile("v_cvt_pk_bf16_f32 %0, %1, %2" : "=v"(r) : "v"(lo), "v"(hi)); return r; }
__device__ __forceinline__ float silu_f(float x) { return x * __builtin_amdgcn_rcpf(1.0f + __builtin_amdgcn_exp2f(-x * LOG2E)); }
__device__ __forceinline__ float wave_sum(float v) {
#pragma unroll
    for (int o = 1; o < 64; o <<= 1) v += __shfl_xor(v, o);
    return v;
}
__device__ __forceinline__ float wave_max(float v) {
#pragma unroll
    for (int o = 1; o < 64; o <<= 1) v = fmaxf(v, __shfl_xor(v, o));
    return v;
}

#define XB_TMO      128
#define XB_XCNT(j)  (256  + 64 * (j))
#define XB_XSUB(j)  (1280 + 64 * (j))
#define XB_XGEN(j)  (2304 + 64 * (j))
#define XB_TOP      3328
#define XB_TOPGEN   3392
#define XCD_BAR_WORDS 3456
#define XB_SPIN_CAP (1u << 18)
__device__ __forceinline__ unsigned xb_ld(unsigned* p)              { return __hip_atomic_load(p, __ATOMIC_RELAXED, __HIP_MEMORY_SCOPE_AGENT); }
__device__ __forceinline__ unsigned xb_add(unsigned* p, unsigned v) { return __hip_atomic_fetch_add(p, v, __ATOMIC_RELAXED, __HIP_MEMORY_SCOPE_AGENT); }
__device__ __forceinline__ unsigned xb_xcc_id() { return (unsigned)__builtin_amdgcn_s_getreg((3 << 11) | 20) & 0xFu; }
#define XB_SPIN(cond, bar) do { unsigned _sp = 0; while (cond) { __builtin_amdgcn_s_sleep(1); \
    if ((++_sp & 255u) == 0u) { if (xb_ld(&(bar)[XB_TMO])) break; if (_sp > XB_SPIN_CAP) { atomicAdd(&(bar)[XB_TMO], 1u); break; } } } } while (0)
struct XcdBarrier { unsigned* bar; unsigned x; volatile LAS unsigned* st; int wave; };
__device__ __forceinline__ XcdBarrier xcd_barrier_post(unsigned* bar, volatile LAS unsigned* st, int wave) {
    XcdBarrier b; b.bar = bar; b.x = xb_xcc_id(); b.st = st; b.wave = wave;
    if (wave == 0 && lane_id() == 0) (void)xb_add(&bar[XB_XCNT(b.x)], 1u);
    return b;
}
__device__ __forceinline__ void xcd_barrier_complete(unsigned* bar, unsigned x, unsigned& nloc, unsigned& nx) {
    const unsigned G = gridDim.x * gridDim.y * gridDim.z;
    unsigned sum, cnt, mine, sp = 0u;
    for (;;) {
        sum = 0u; cnt = 0u; mine = 0u;
#pragma unroll
        for (unsigned j = 0; j < 16; ++j) { const unsigned c = xb_ld(&bar[XB_XCNT(j)]); sum += c; cnt += (c > 0u) ? 1u : 0u; mine = (j == x) ? c : mine; }
        if (sum == G) break;
        __builtin_amdgcn_s_sleep(1);
        if ((++sp & 255u) == 0u) { if (xb_ld(&bar[XB_TMO])) break; if (sp > XB_SPIN_CAP) { atomicAdd(&bar[XB_TMO], 1u); break; } }
    }
    nloc = mine > 0u ? mine : 1u; nx = cnt > 0u ? cnt : 1u;
}
__device__ __forceinline__ void xcd_barrier(const XcdBarrier& b) {
    asm volatile("s_waitcnt vmcnt(0)" ::: "memory");
    __syncthreads();
    if (b.wave == 0 && lane_id() == 0) {
        unsigned* bar = b.bar;
        __builtin_amdgcn_s_waitcnt(0);
        unsigned nloc = b.st[0], nx = b.st[1];
        if (nloc == 0u) { xcd_barrier_complete(bar, b.x, nloc, nx); b.st[0] = nloc; b.st[1] = nx; }
        const unsigned old = xb_add(&bar[XB_XSUB(b.x)], 1u);
        const unsigned gen = old / nloc;
        if (old + 1u == (gen + 1u) * nloc) {
            __builtin_amdgcn_fence(__ATOMIC_RELEASE, "agent");
            asm volatile("s_waitcnt vmcnt(0)" ::: "memory");
            const unsigned og = xb_add(&bar[XB_TOP], 1u);
            const unsigned tg = og / nx;
            if (og + 1u == (tg + 1u) * nx) xb_add(&bar[XB_TOPGEN], 1u);
            else XB_SPIN(xb_ld(&bar[XB_TOPGEN]) == tg, bar);
            __builtin_amdgcn_fence(__ATOMIC_ACQUIRE, "agent");
            xb_add(&bar[XB_XGEN(b.x)], 1u);
            asm volatile("s_waitcnt vmcnt(0)" ::: "memory");
        } else {
            XB_SPIN(xb_ld(&bar[XB_XGEN(b.x)]) == gen, bar);
            __builtin_amdgcn_fence(__ATOMIC_ACQUIRE, "agent");
            asm volatile("s_waitcnt vmcnt(0)" ::: "memory");
        }
    }
    __syncthreads();
}

constexpr int NWAVES = 8;
constexpr int RING_OFF = 0, RING_BYTES = 131072;
constexpr int LDSCTL_OFF = RING_BYTES, MISC_OFF = LDSCTL_OFF + 320;
constexpr int LDS_BYTES = 147456;

struct Args { const void* in[16]; float* out; unsigned char* ws; int ph_lo, ph_hi, dummy, pad; };
struct Frame {
    LAS unsigned char* lds;
    volatile LAS unsigned* MISC;
    gu32* ctl;
    int wave, vcu, G;
    const Args* ap;
    __device__ __forceinline__ int lane() const { return lane_id(); }
    __device__ __forceinline__ int tid() const { return wave * 64 + lane_id(); }
    __device__ __forceinline__ void refresh() { const Args* a = (const Args*)__builtin_amdgcn_kernarg_segment_ptr(); asm volatile("" : "+s"(a)); ap = a; }
#define FIN(name, idx, T) __device__ __forceinline__ const T* name() const { return (const T*)ap->in[idx]; }
    FIN(x, 0, float) FIN(mem, 1, float) FIN(positions, 2, int) FIN(norm_g, 3, float) FIN(mem_norm_g, 4, float) FIN(w_mem_kv, 5, float) FIN(w_out, 6, float) FIN(pool_w_in, 7, float)
    FIN(pool_w_group, 8, float) FIN(pool_scale, 9, float) FIN(mla_w_in, 10, float) FIN(mla_q_norm_g, 11, float) FIN(mla_w_uq, 12, float) FIN(mla_kv_norm_g, 13, float) FIN(mla_w_ukv, 14, float) FIN(final_norm_g, 15, float)
#undef FIN
    __device__ __forceinline__ float* out() const { return ap->out; }
    __device__ __forceinline__ unsigned char* ws() const { return ap->ws; }
#define FWS(name, off, T) __device__ __forceinline__ T* name() const { return (T*)(ap->ws + (off)); }
    FWS(WIN0, WS_WIN0, bf16_t) FWS(WMKV, WS_WMKV, bf16_t) FWS(WOUT0, WS_WOUT0, bf16_t) FWS(WOUT1, WS_WOUT1, bf16_t) FWS(WIN1, WS_WIN1, bf16_t) FWS(WUQ, WS_WUQ, bf16_t) FWS(WUKV, WS_WUKV, bf16_t)
    FWS(XN, WS_XN, bf16_t) FWS(MN, WS_MN, bf16_t) FWS(MEMKV, WS_MEMKV, bf16_t) FWS(PROJ, WS_PROJ, bf16_t) FWS(BR, WS_BR, bf16_t) FWS(Q, WS_Q, bf16_t) FWS(KN, WS_KN, bf16_t) FWS(VV, WS_VV, bf16_t)
    FWS(CS, WS_CS, float) FWS(ssq1, WS_SSQ, float) FWS(ssq_q, WS_SSQ + (size_t)M * 4, float) FWS(ssq_kv, WS_SSQ + (size_t)M * 8, float) FWS(ssq2, WS_SSQ + (size_t)M * 12, float)
#undef FWS
};

template <int MODE>
__device__ __forceinline__ int src_col(int n) {
    if (MODE == 1) { if (n >= L1_KR && n < L1_MQ) { const int j = n - L1_KR; return L1_KR + (j >> 1) + 32 * (j & 1); } return n; }
    if (MODE == 2) { const int h = n / 192, d = n - h * 192; if (d >= 128) { const int j = d - 128; return h * 192 + 128 + (j >> 1) + 32 * (j & 1); } return n; }
    return n;
}
__device__ __forceinline__ void transpose_writeout(LAS float* scr, bf16_t* WT, int K, int row0, int k0, int lane) {
    LDS_WAIT(); asm volatile("" ::: "memory");
    const int c = lane & 7;
#pragma unroll
    for (int j = 0; j < 4; ++j) { const int n = (lane >> 3) + 8 * j; const LAS float* s = scr + (8 * c) * 33 + n;
        u32x4 o; o.x = pk2(s[0 * 33], s[1 * 33]); o.y = pk2(s[2 * 33], s[3 * 33]); o.z = pk2(s[4 * 33], s[5 * 33]); o.w = pk2(s[6 * 33], s[7 * 33]);
        *(GAS u32x4*)(WT + (size_t)(row0 + n) * K + k0 + 8 * c) = o; }
    LDS_WAIT(); asm volatile("" ::: "memory");
}
template <int MODE>
__device__ __forceinline__ void p0_transpose_item(const float* W, int ldw, int col0, int nsrc, int K, int Ndst, const float* gain, bf16_t* WT, LAS float* scr, int item, int lane) {
    const int nblk = Ndst / 32, kb = item / nblk, nb = item % nblk, k0 = 64 * kb, n0 = 32 * nb;
    const int sc = src_col<MODE>(n0 + (lane & 31)); const bool ok = sc < nsrc;
    float tv[32];
#pragma unroll
    for (int i = 0; i < 32; ++i) { const int kk = 2 * i + (lane >> 5); tv[i] = ok ? W[(size_t)(k0 + kk) * ldw + col0 + sc] : 0.f; }
    if (gain) {
#pragma unroll
        for (int i = 0; i < 32; ++i) tv[i] *= gain[k0 + 2 * i + (lane >> 5)]; }
#pragma unroll
    for (int i = 0; i < 32; ++i) scr[(2 * i + (lane >> 5)) * 33 + (lane & 31)] = tv[i];
    transpose_writeout(scr, WT, K, n0, k0, lane);
}
__device__ __forceinline__ void p0_fold_item(const float* Win, const float* wg, const float* scale, bf16_t* WT, LAS float* scr, int item, int lane) {
    const int nblk = 768 / 32, kb = item / nblk, nb = item % nblk, k0 = 16 * kb, n0 = 32 * nb, g = n0 / 192, d = n0 - g * 192 + (lane & 31), half = lane >> 5;
    const float* wgc = wg + (size_t)g * 192 * 192 + d;
    float acc[8];
#pragma unroll
    for (int j = 0; j < 8; ++j) acc[j] = 0.f;
    const int arow = lane >> 2, ac = (lane & 3) * 16;
#pragma unroll 1
    for (int ch = 0; ch < 3; ++ch) {
        float wv[64]; f32x4 av[4];
        const f32x4* ap = (const f32x4*)(Win + (size_t)(k0 + arow) * 2048 + g * 192 + ch * 64 + ac);
#pragma unroll
        for (int q = 0; q < 4; ++q) av[q] = ap[q];
#pragma unroll
        for (int c = 0; c < 64; ++c) wv[c] = wgc[(size_t)(ch * 64 + c) * 192];
#pragma unroll
        for (int q = 0; q < 4; ++q) *(LAS f32x4*)(scr + arow * 64 + ac + 4 * q) = av[q];
        LDS_WAIT(); asm volatile("" ::: "memory");
#pragma unroll
        for (int j = 0; j < 8; ++j) { const LAS f32x4* rp = (const LAS f32x4*)(scr + (half + 2 * j) * 64); float a = acc[j];
#pragma unroll
            for (int c4 = 0; c4 < 16; ++c4) { const f32x4 w = rp[c4]; a += w.x * wv[4 * c4] + w.y * wv[4 * c4 + 1] + w.z * wv[4 * c4 + 2] + w.w * wv[4 * c4 + 3]; }
            acc[j] = a; asm volatile("" ::: "memory"); }
        LDS_WAIT(); asm volatile("" ::: "memory");
    }
    const float sc = scale[g * 192 + d];
    LAS float* s2 = scr + 1024;
#pragma unroll
    for (int j = 0; j < 8; ++j) s2[(half + 2 * j) * 33 + (lane & 31)] = acc[j] * sc;
    LDS_WAIT(); asm volatile("" ::: "memory");
    { const int n = lane >> 1, c = lane & 1; const LAS float* sp = s2 + (8 * c) * 33 + n;
      u32x4 o; o.x = pk2(sp[0 * 33], sp[1 * 33]); o.y = pk2(sp[2 * 33], sp[3 * 33]); o.z = pk2(sp[4 * 33], sp[5 * 33]); o.w = pk2(sp[6 * 33], sp[7 * 33]);
      *(GAS u32x4*)(WT + (size_t)(n0 + n) * 1024 + k0 + 8 * c) = o; }
    LDS_WAIT(); asm volatile("" ::: "memory");
}
__device__ __forceinline__ void rms_rows4_to_bf16(const float* x, const float* g, bf16_t* o, int m, int step, int lane) {
    f32x4 v[4][4]; float ss[4];
#pragma unroll
    for (int r = 0; r < 4; ++r) { const GAS f32x4* xr = (const GAS f32x4*)(x + (size_t)(m + r * step) * DM) + lane;
#pragma unroll
        for (int j = 0; j < 4; ++j) v[r][j] = xr[64 * j]; }
#pragma unroll
    for (int r = 0; r < 4; ++r) { float a = 0.f;
#pragma unroll
        for (int j = 0; j < 4; ++j) a += (v[r][j].x * v[r][j].x + v[r][j].y * v[r][j].y) + (v[r][j].z * v[r][j].z + v[r][j].w * v[r][j].w);
        ss[r] = 1.0f / sqrtf(wave_sum(a) * (1.f / 1024.f) + EPS); }
    const GAS f32x4* gr = (const GAS f32x4*)g + lane;
#pragma unroll
    for (int j = 0; j < 4; ++j) { const f32x4 gg = gr[64 * j];
#pragma unroll
        for (int r = 0; r < 4; ++r) { GAS unsigned long long* o8 = (GAS unsigned long long*)(o + (size_t)(m + r * step) * DM) + lane; const float rs = ss[r];
            o8[64 * j] = (unsigned long long)pk2(v[r][j].x * rs * gg.x, v[r][j].y * rs * gg.y) | ((unsigned long long)pk2(v[r][j].z * rs * gg.z, v[r][j].w * rs * gg.w) << 32); } }
}
__device__ __forceinline__ void sincos_acc(float ang, float& c, float& s) {
    const double x = (double)ang;
    const double q = __builtin_rint(x * 0.63661977236758134308);
    double y = __builtin_fma(-q, 1.57079632679489655800e+00, x); y = __builtin_fma(-q, 6.12323399573676603587e-17, y);
    const double y2 = y * y;
    double sp = -1.0 / 1307674368000.0; sp = sp * y2 + 1.0 / 6227020800.0; sp = sp * y2 - 1.0 / 39916800.0; sp = sp * y2 + 1.0 / 362880.0; sp = sp * y2 - 1.0 / 5040.0; sp = sp * y2 + 1.0 / 120.0; sp = sp * y2 - 1.0 / 6.0; sp = sp * y2 * y + y;
    double cp = 1.0 / 20922789888000.0; cp = cp * y2 - 1.0 / 87178291200.0; cp = cp * y2 + 1.0 / 479001600.0; cp = cp * y2 - 1.0 / 3628800.0; cp = cp * y2 + 1.0 / 40320.0; cp = cp * y2 - 1.0 / 720.0; cp = cp * y2 + 1.0 / 24.0; cp = cp * y2 - 0.5; cp = cp * y2 + 1.0;
    const int n = (int)q & 3;
    const double ss = (n & 1) ? cp : sp, cc = (n & 1) ? sp : cp;
    s = (float)((n & 2) ? -ss : ss); c = (float)(((n + 1) & 2) ? -cc : cc);
}
__device__ __forceinline__ void p0_prologue(Frame& F) {
    LAS float* scr = (LAS float*)(F.lds + RING_OFF + F.wave * 16384);
    const int gw = F.vcu * NWAVES + F.wave, NGW = F.G * NWAVES;
    constexpr int I_FOLD = 64 * 24, I_IN0 = 16 * 40, I_MKV = 16 * 16, I_OUT = 16 * 32, I_IN1 = 16 * 64, I_UQ = 6 * 40, I_UKV = 4 * 48;
    constexpr int NITEMS = I_FOLD + I_IN0 + 2 * I_MKV + 2 * I_OUT + I_IN1 + I_UQ + I_UKV;
    for (int it = gw; it < NITEMS; it += NGW) {
        int r = it;
        if (r < I_FOLD) { p0_fold_item(F.pool_w_in(), F.pool_w_group(), F.pool_scale(), F.WIN0(), scr, r, F.lane()); continue; } r -= I_FOLD;
        if (r < I_IN0) { p0_transpose_item<0>(F.pool_w_in(), 2048, 768, 1280, 1024, 1280, nullptr, F.WIN0() + (size_t)768 * 1024, scr, r, F.lane()); continue; } r -= I_IN0;
        if (r < I_MKV) { p0_transpose_item<0>(F.w_mem_kv(), 512, 0, 512, 1024, 512, nullptr, F.WMKV(), scr, r, F.lane()); continue; } r -= I_MKV;
        if (r < I_MKV) { p0_transpose_item<0>(F.w_mem_kv() + (size_t)1024 * 512, 512, 0, 512, 1024, 512, nullptr, F.WMKV() + (size_t)512 * 1024, scr, r, F.lane()); continue; } r -= I_MKV;
        if (r < I_OUT) { p0_transpose_item<0>(F.w_out(), 1024, 0, 1024, 1024, 1024, nullptr, F.WOUT0(), scr, r, F.lane()); continue; } r -= I_OUT;
        if (r < I_OUT) { p0_transpose_item<0>(F.w_out() + (size_t)1024 * 1024, 1024, 0, 1024, 1024, 1024, nullptr, F.WOUT1(), scr, r, F.lane()); continue; } r -= I_OUT;
        if (r < I_IN1) { p0_transpose_item<1>(F.mla_w_in(), 1984, 0, 1984, 1024, 2048, F.norm_g() + 1024, F.WIN1(), scr, r, F.lane()); continue; } r -= I_IN1;
        if (r < I_UQ) { p0_transpose_item<2>(F.mla_w_uq(), 1152, 0, 1152, 384, 1280, F.mla_q_norm_g(), F.WUQ(), scr, r, F.lane()); continue; } r -= I_UQ;
        p0_transpose_item<0>(F.mla_w_ukv(), 1536, 0, 1536, 256, 1536, F.mla_kv_norm_g(), F.WUKV(), scr, r, F.lane());
    }
    for (int m = gw; m < M; m += 4 * NGW) rms_rows4_to_bf16(F.x(), F.norm_g(), F.XN(), m, NGW, F.lane());
    if (gw < MROWS / 4) rms_rows4_to_bf16(F.mem(), F.mem_norm_g(), F.MN(), gw, MROWS / 4, F.lane());
    { const int gt = F.vcu * NWAVES * 64 + F.tid(), NTH = F.G * NWAVES * 64;
      for (int e0 = gt; e0 < M * 32; e0 += 8 * NTH) {
        int pos[8];
#pragma unroll
        for (int q = 0; q < 8; ++q) { const int e = e0 + q * NTH; pos[q] = e < M * 32 ? F.positions()[e >> 5] : 0; }
#pragma unroll
        for (int q = 0; q < 8; ++q) { const int e = e0 + q * NTH; if (e < M * 32) { const int i = e & 31;
            const float inv = __builtin_amdgcn_exp2f(-(float)(2 * i) * (1.0f / 64.0f) * 13.287712379549449f);
            float c, sn; sincos_acc((float)pos[q] * inv, c, sn);
            *(GAS f32x2*)(F.CS() + (size_t)e * 2) = (f32x2){c, sn}; } } } }
}

struct EpiP1 {
    static constexpr bool PERM = true;
    bf16_t* proj; bf16_t* memkv;
    __device__ __forceinline__ void operator()(const f32x4 (&acc)[2][2][4][2], const pg8::Unit& u, int wr, int wc, int fr, int fq) const {
        const int row0 = u.pm * 256 + wr * 64 + fr, col0 = u.pn * 256 + wc * 32 + 8 * fq;
        bf16_t* base = u.g ? memkv : proj; const int ld = u.g ? 1024 : PLD;
        const int kind = u.g ? 0 : (u.pn < 3 ? 0 : (u.pn == 3 ? 1 : 2));
#pragma unroll
        for (int ai = 0; ai < 2; ++ai)
#pragma unroll
            for (int m = 0; m < 4; ++m) { bf16_t* rowp = base + (size_t)(row0 + ai * 128 + m * 16) * ld + col0;
#pragma unroll
                for (int bj = 0; bj < 2; ++bj) { f32x4 v0 = acc[ai][bj][m][0], v1 = acc[ai][bj][m][1];
                    if (kind == 1) { v0 = v0 * MQ_C2; v1 = v1 * MQ_C2; }
                    else if (kind == 2) {
#pragma unroll
                        for (int e = 0; e < 4; ++e) { v0[e] = silu_f(v0[e]); v1[e] = silu_f(v1[e]); } }
                    u32x4 w; w.x = cvt_pk_bf16(v0[0], v0[1]); w.y = cvt_pk_bf16(v0[2], v0[3]); w.z = cvt_pk_bf16(v1[0], v1[1]); w.w = cvt_pk_bf16(v1[2], v1[3]);
                    *(u32x4*)(rowp + bj * 128) = w; } }
    }
};
struct EpiOut0 {
    static constexpr bool PERM = true;
    const float* base; bf16_t* outb; float* ssq;
    __device__ __forceinline__ void operator()(const f32x4 (&acc)[2][2][4][2], const pg8::Unit& u, int wr, int wc, int fr, int fq) const {
        const int col0 = u.pn * 256 + wc * 32 + 8 * fq;
#pragma unroll
        for (int ai = 0; ai < 2; ++ai)
#pragma unroll
            for (int m = 0; m < 4; ++m) { const int row = u.pm * 256 + ai * 128 + wr * 64 + m * 16 + fr; const size_t off = (size_t)row * DM + col0; float s = 0.f;
#pragma unroll
                for (int bj = 0; bj < 2; ++bj) { const f32x4 h0 = *(const f32x4*)(base + off + bj * 128) + acc[ai][bj][m][0], h1 = *(const f32x4*)(base + off + bj * 128 + 4) + acc[ai][bj][m][1];
                    s += (h0[0] * h0[0] + h0[1] * h0[1]) + (h0[2] * h0[2] + h0[3] * h0[3]) + (h1[0] * h1[0] + h1[1] * h1[1]) + (h1[2] * h1[2] + h1[3] * h1[3]);
                    u32x4 w; w.x = cvt_pk_bf16(h0[0], h0[1]); w.y = cvt_pk_bf16(h0[2], h0[3]); w.z = cvt_pk_bf16(h1[0], h1[1]); w.w = cvt_pk_bf16(h1[2], h1[3]);
                    *(u32x4*)(outb + off + bj * 128) = w; }
                s += __shfl_xor(s, 16); s += __shfl_xor(s, 32);
                if (fq == 0) atomicAdd(ssq + row, s); asm volatile("" ::: "memory"); }
    }
};
struct EpiOut1 {
    static constexpr bool PERM = true;
    const bf16_t* base; float* out; float* ssq;
    __device__ __forceinline__ void operator()(const f32x4 (&acc)[2][2][4][2], const pg8::Unit& u, int wr, int wc, int fr, int fq) const {
        const int col0 = u.pn * 256 + wc * 32 + 8 * fq;
#pragma unroll
        for (int ai = 0; ai < 2; ++ai)
#pragma unroll
            for (int m = 0; m < 4; ++m) { const int row = u.pm * 256 + ai * 128 + wr * 64 + m * 16 + fr; const size_t off = (size_t)row * DM + col0; float s = 0.f;
#pragma unroll
                for (int bj = 0; bj < 2; ++bj) { const u32x4 b = *(const u32x4*)(base + off + bj * 128);
                    const f32x4 h0 = (f32x4){bflo(b.x), bfhi(b.x), bflo(b.y), bfhi(b.y)} + acc[ai][bj][m][0], h1 = (f32x4){bflo(b.z), bfhi(b.z), bflo(b.w), bfhi(b.w)} + acc[ai][bj][m][1];
                    s += (h0[0] * h0[0] + h0[1] * h0[1]) + (h0[2] * h0[2] + h0[3] * h0[3]) + (h1[0] * h1[0] + h1[1] * h1[1]) + (h1[2] * h1[2] + h1[3] * h1[3]);
                    *(f32x4*)(out + off + bj * 128) = h0; *(f32x4*)(out + off + bj * 128 + 4) = h1; }
                s += __shfl_xor(s, 16); s += __shfl_xor(s, 32);
                if (fq == 0) atomicAdd(ssq + row, s); asm volatile("" ::: "memory"); }
    }
};
__device__ __forceinline__ f32x4 rope4(f32x4 v, f32x4 cs) { return (f32x4){v[0] * cs[0] - v[1] * cs[1], v[1] * cs[0] + v[0] * cs[1], v[2] * cs[2] - v[3] * cs[3], v[3] * cs[2] + v[2] * cs[3]}; }
struct EpiP4 {
    static constexpr bool PERM = true;
    bf16_t* proj; const float* ssq1; float* ssq_q; float* ssq_kv; const float* cs;
    __device__ __forceinline__ void operator()(const f32x4 (&acc)[2][2][4][2], const pg8::Unit& u, int wr, int wc, int fr, int fq) const {
        const int row0 = u.pm * 256 + wr * 64 + fr;
#pragma unroll
        for (int bj = 0; bj < 2; ++bj) {
            const int cw = u.pn * 256 + bj * 128 + wc * 32;
            const int kind = cw < L1_CKV ? 0 : cw < L1_KR ? 1 : cw < L1_MQ ? 2 : cw < L1_GATE ? 3 : cw < L1_END ? 4 : 5;
            if (kind == 5) continue;
            const int col0 = cw + 8 * fq;
#pragma unroll
            for (int ai = 0; ai < 2; ++ai)
#pragma unroll
                for (int m = 0; m < 4; ++m) { const int row = row0 + ai * 128 + m * 16;
                    const float r = 1.0f / sqrtf(ssq1[row] * (1.f / 1024.f) + EPS);
                    f32x4 v0 = acc[ai][bj][m][0] * r, v1 = acc[ai][bj][m][1] * r;
                    if (kind <= 1) { float s = (v0[0] * v0[0] + v0[1] * v0[1]) + (v0[2] * v0[2] + v0[3] * v0[3]) + (v1[0] * v1[0] + v1[1] * v1[1]) + (v1[2] * v1[2] + v1[3] * v1[3]);
                        s += __shfl_xor(s, 16); s += __shfl_xor(s, 32); if (fq == 0) atomicAdd((kind == 0 ? ssq_q : ssq_kv) + row, s); }
                    else if (kind == 2) { const int i0 = (col0 - L1_KR) >> 1; const f32x4* cp = (const f32x4*)(cs + ((size_t)row * 32 + i0) * 2); v0 = rope4(v0, cp[0]); v1 = rope4(v1, cp[1]); }
                    else if (kind == 3) { v0 = v0 * MQ_C2; v1 = v1 * MQ_C2; }
                    else {
#pragma unroll
                        for (int e = 0; e < 4; ++e) { v0[e] = silu_f(v0[e]); v1[e] = silu_f(v1[e]); } }
                    u32x4 w; w.x = cvt_pk_bf16(v0[0], v0[1]); w.y = cvt_pk_bf16(v0[2], v0[3]); w.z = cvt_pk_bf16(v1[0], v1[1]); w.w = cvt_pk_bf16(v1[2], v1[3]);
                    *(u32x4*)(proj + (size_t)row * PLD + col0) = w; asm volatile("" ::: "memory"); }
        }
    }
};
struct EpiQ {
    static constexpr bool PERM = true;
    bf16_t* q; const float* ssq_q; const float* cs;
    __device__ __forceinline__ void operator()(const f32x4 (&acc)[2][2][4][2], const pg8::Unit& u, int wr, int wc, int fr, int fq) const {
        const int row0 = u.pm * 256 + wr * 64 + fr;
#pragma unroll
        for (int bj = 0; bj < 2; ++bj) {
            const int col0 = u.pn * 256 + bj * 128 + wc * 32 + 8 * fq;
            if (u.pn * 256 + bj * 128 >= QLD) continue;
            const int d = col0 % 192; const bool rope = d >= 128; const int i0 = rope ? (d - 128) >> 1 : 0;
#pragma unroll
            for (int ai = 0; ai < 2; ++ai)
#pragma unroll
                for (int m = 0; m < 4; ++m) { const int row = row0 + ai * 128 + m * 16;
                    const float r = Q_C2 / sqrtf(ssq_q[row] * (1.f / 384.f) + EPS);
                    f32x4 v0 = acc[ai][bj][m][0] * r, v1 = acc[ai][bj][m][1] * r;
                    if (rope) { const f32x4* cp = (const f32x4*)(cs + ((size_t)row * 32 + i0) * 2); v0 = rope4(v0, cp[0]); v1 = rope4(v1, cp[1]); }
                    u32x4 w; w.x = cvt_pk_bf16(v0[0], v0[1]); w.y = cvt_pk_bf16(v0[2], v0[3]); w.z = cvt_pk_bf16(v1[0], v1[1]); w.w = cvt_pk_bf16(v1[2], v1[3]);
                    *(u32x4*)(q + (size_t)row * QLD + col0) = w; asm volatile("" ::: "memory"); }
        }
    }
};
struct EpiKV {
    static constexpr bool PERM = true;
    bf16_t* kn; bf16_t* vv; const float* ssq_kv;
    __device__ __forceinline__ void operator()(const f32x4 (&acc)[2][2][4][2], const pg8::Unit& u, int wr, int wc, int fr, int fq) const {
        const int row0 = u.pm * 256 + wr * 64 + fr, col0 = u.pn * 128 + wc * 32 + 8 * fq;
#pragma unroll
        for (int ai = 0; ai < 2; ++ai)
#pragma unroll
            for (int m = 0; m < 4; ++m) { const int row = row0 + ai * 128 + m * 16;
                const float r = 1.0f / sqrtf(ssq_kv[row] * (1.f / 256.f) + EPS);
#pragma unroll
                for (int bj = 0; bj < 2; ++bj) { const f32x4 v0 = acc[ai][bj][m][0] * r, v1 = acc[ai][bj][m][1] * r;
                    u32x4 w; w.x = cvt_pk_bf16(v0[0], v0[1]); w.y = cvt_pk_bf16(v0[2], v0[3]); w.z = cvt_pk_bf16(v1[0], v1[1]); w.w = cvt_pk_bf16(v1[2], v1[3]);
                    *(u32x4*)((bj ? vv : kn) + (size_t)row * KLD + col0) = w; } asm volatile("" ::: "memory"); }
    }
};

__device__ __forceinline__ void bf8_unpack(const u32x4 w, float (&f)[8]) { f[0] = bflo(w.x); f[1] = bfhi(w.x); f[2] = bflo(w.y); f[3] = bfhi(w.y); f[4] = bflo(w.z); f[5] = bfhi(w.z); f[6] = bflo(w.w); f[7] = bfhi(w.w); }
template <int W>
__device__ __forceinline__ void pool_item(const bf16_t* PROJ, bf16_t* BR, int g, int j) {
    const int run = j / 24, c24 = j - run * 24, col = g * 192 + c24 * 8, t0 = run * 8, s0 = t0 & (SEQ - 1);
    constexpr int NL = W + 7;
    u32x4 zr[NL], gr[8];
    const bf16_t* zp = PROJ + (size_t)t0 * PLD + col;
#pragma unroll
    for (int i = 0; i < NL; ++i) { const int ds = i - (W - 1); zr[i] = (s0 + ds >= 0) ? *(const u32x4*)(zp + (ptrdiff_t)ds * PLD) : (u32x4){0u, 0u, 0u, 0u}; }
#pragma unroll
    for (int k = 0; k < 8; ++k) gr[k] = *(const u32x4*)(PROJ + (size_t)(t0 + k) * PLD + L0_GATE + col);
    float S[8], f[8], h[8];
#pragma unroll
    for (int e = 0; e < 8; ++e) S[e] = 0.f;
#pragma unroll
    for (int i = 0; i < W - 1; ++i) { bf8_unpack(zr[i], f);
#pragma unroll
        for (int e = 0; e < 8; ++e) S[e] += f[e]; }
#pragma unroll
    for (int k = 0; k < 8; ++k) {
        bf8_unpack(zr[k + W - 1], f);
#pragma unroll
        for (int e = 0; e < 8; ++e) S[e] += f[e];
        const int cn = (s0 + k + 1 < W) ? s0 + k + 1 : W; const float ic = 1.0f / (float)cn;
        bf8_unpack(gr[k], h);
        float o[8];
#pragma unroll
        for (int e = 0; e < 8; ++e) o[e] = (S[e] * ic - f[e]) * h[e];
        u32x4 w4; w4.x = pk2(o[0], o[1]); w4.y = pk2(o[2], o[3]); w4.z = pk2(o[4], o[5]); w4.w = pk2(o[6], o[7]);
        *(u32x4*)(BR + (size_t)(t0 + k) * DM + col) = w4;
        bf8_unpack(zr[k], f);
#pragma unroll
        for (int e = 0; e < 8; ++e) S[e] -= f[e];
    }
}
__device__ __forceinline__ void pool_phase(Frame& F) {
    const int gw = F.vcu * NWAVES + F.wave, NGW = F.G * NWAVES, lane = F.lane();
    constexpr int WPG = (M / 8) * 24 / 64;
    const bf16_t* PROJ = F.PROJ(); bf16_t* BR = F.BR();
    for (int wi = gw; wi < 4 * WPG; wi += NGW) {
        const int g = wi / WPG, j = (wi - g * WPG) * 64 + lane;
        if (g == 0) pool_item<2>(PROJ, BR, 0, j); else if (g == 1) pool_item<4>(PROJ, BR, 1, j); else if (g == 2) pool_item<8>(PROJ, BR, 2, j); else pool_item<16>(PROJ, BR, 3, j);
    }
}
__device__ __forceinline__ void memattn_naive(Frame& F, int layer, int mq_col, int gate_col) {
    const int gw = F.vcu * NWAVES + F.wave, NGW = F.G * NWAVES, lane = F.lane();
    for (int it = gw; it < M * 4; it += NGW) {
        const int t = it >> 2, h = it & 3, b = t / SEQ;
        const bf16_t* qp = F.PROJ() + (size_t)t * PLD + mq_col + h * 64;
        float q[64];
#pragma unroll
        for (int c = 0; c < 8; ++c) { const u32x4 w = *(const u32x4*)(qp + 8 * c);
            q[8 * c] = bflo(w.x); q[8 * c + 1] = bfhi(w.x); q[8 * c + 2] = bflo(w.y); q[8 * c + 3] = bfhi(w.y); q[8 * c + 4] = bflo(w.z); q[8 * c + 5] = bfhi(w.z); q[8 * c + 6] = bflo(w.w); q[8 * c + 7] = bfhi(w.w); }
        const bf16_t* kb = F.MEMKV() + (size_t)(b * NMEM) * 1024 + layer * 512 + h * 64;
        float sc[4];
#pragma unroll
        for (int j = 0; j < 4; ++j) { const bf16_t* kp = kb + (size_t)(j * 64 + lane) * 1024; float a = 0.f;
#pragma unroll
            for (int c = 0; c < 8; ++c) { const u32x4 w = *(const u32x4*)(kp + 8 * c);
                a += q[8 * c] * bflo(w.x) + q[8 * c + 1] * bfhi(w.x) + q[8 * c + 2] * bflo(w.y) + q[8 * c + 3] * bfhi(w.y) + q[8 * c + 4] * bflo(w.z) + q[8 * c + 5] * bfhi(w.z) + q[8 * c + 6] * bflo(w.w) + q[8 * c + 7] * bfhi(w.w); }
            sc[j] = a; }
        const float mx = wave_max(fmaxf(fmaxf(sc[0], sc[1]), fmaxf(sc[2], sc[3])));
        float p[4], ls = 0.f;
#pragma unroll
        for (int j = 0; j < 4; ++j) { p[j] = __builtin_amdgcn_exp2f(sc[j] - mx); ls += p[j]; }
        const float l = wave_sum(ls);
        const bf16_t* vb = kb + 256 + lane; float o = 0.f;
#pragma unroll
        for (int j = 0; j < 4; ++j)
            for (int s = 0; s < 64; ++s) { const float pp = __shfl(p[j], s); o += pp * bf2f(vb[(size_t)(j * 64 + s) * 1024]); }
        const float gt = bf2f(F.PROJ()[(size_t)t * PLD + gate_col + 768 + h * 64 + lane]);
        F.BR()[(size_t)t * DM + 768 + h * 64 + lane] = (bf16_t)f2bf(o / l * gt);
    }
}
__device__ __forceinline__ void mla_naive(Frame& F) {
    const int gw = F.vcu * NWAVES + F.wave, NGW = F.G * NWAVES, lane = F.lane(), sub = lane & 7, kq = lane >> 3;
    LAS float* scs = (LAS float*)(F.lds + RING_OFF) + F.wave * 2048;
    for (int it = gw; it < M * 6; it += NGW) {
        const int h = it % 6, t = it / 6, b = t / SEQ, s = t & (SEQ - 1), nk = ((s >> 6) + 1) * 64;
        const bf16_t* qp = F.Q() + (size_t)t * QLD + h * 192;
        float q[24];
        { const u32x4 w0 = *(const u32x4*)(qp + 8 * sub), w1 = *(const u32x4*)(qp + 64 + 8 * sub), w2 = *(const u32x4*)(qp + 128 + 8 * sub);
          q[0] = bflo(w0.x); q[1] = bfhi(w0.x); q[2] = bflo(w0.y); q[3] = bfhi(w0.y); q[4] = bflo(w0.z); q[5] = bfhi(w0.z); q[6] = bflo(w0.w); q[7] = bfhi(w0.w);
          q[8] = bflo(w1.x); q[9] = bfhi(w1.x); q[10] = bflo(w1.y); q[11] = bfhi(w1.y); q[12] = bflo(w1.z); q[13] = bfhi(w1.z); q[14] = bflo(w1.w); q[15] = bfhi(w1.w);
          q[16] = bflo(w2.x); q[17] = bfhi(w2.x); q[18] = bflo(w2.y); q[19] = bfhi(w2.y); q[20] = bflo(w2.z); q[21] = bfhi(w2.z); q[22] = bflo(w2.w); q[23] = bfhi(w2.w); }
        const size_t r0 = (size_t)b * SEQ;
        float mx = -3.0e38f;
        for (int kg = 0; kg < nk; kg += 8) { const int key = kg + kq;
            const bf16_t* kn = F.KN() + (r0 + key) * KLD + h * 128 + 8 * sub; const bf16_t* kr = F.PROJ() + (r0 + key) * PLD + L1_KR + 8 * sub;
            const u32x4 w0 = *(const u32x4*)kn, w1 = *(const u32x4*)(kn + 64), w2 = *(const u32x4*)kr;
            float a = q[0] * bflo(w0.x) + q[1] * bfhi(w0.x) + q[2] * bflo(w0.y) + q[3] * bfhi(w0.y) + q[4] * bflo(w0.z) + q[5] * bfhi(w0.z) + q[6] * bflo(w0.w) + q[7] * bfhi(w0.w);
            a += q[8] * bflo(w1.x) + q[9] * bfhi(w1.x) + q[10] * bflo(w1.y) + q[11] * bfhi(w1.y) + q[12] * bflo(w1.z) + q[13] * bfhi(w1.z) + q[14] * bflo(w1.w) + q[15] * bfhi(w1.w);
            a += q[16] * bflo(w2.x) + q[17] * bfhi(w2.x) + q[18] * bflo(w2.y) + q[19] * bfhi(w2.y) + q[20] * bflo(w2.z) + q[21] * bfhi(w2.z) + q[22] * bflo(w2.w) + q[23] * bfhi(w2.w);
            a += __shfl_xor(a, 1); a += __shfl_xor(a, 2); a += __shfl_xor(a, 4);
            mx = fmaxf(mx, a);
            if (sub == 0) scs[key] = a; }
        mx = wave_max(mx);
        LDS_WAIT(); asm volatile("" ::: "memory");
        float ls = 0.f;
        for (int k = lane; k < nk; k += 64) { const float p = __builtin_amdgcn_exp2f(scs[k] - mx); scs[k] = p; ls += p; }
        const float l = wave_sum(ls);
        LDS_WAIT(); asm volatile("" ::: "memory");
        const bf16_t* vp = F.VV() + r0 * KLD + h * 128 + 2 * lane; float o0 = 0.f, o1 = 0.f;
        for (int k = 0; k < nk; ++k) { const float p = scs[k]; const unsigned w = *(const unsigned*)(vp + (size_t)k * KLD); o0 += p * bflo(w); o1 += p * bfhi(w); }
        const unsigned gw2 = *(const unsigned*)(F.PROJ() + (size_t)t * PLD + L1_GATE + h * 128 + 2 * lane);
        const float il = 1.0f / l;
        *(unsigned*)(F.BR() + (size_t)t * DM + h * 128 + 2 * lane) = pk2(o0 * il * bflo(gw2), o1 * il * bfhi(gw2));
        LDS_WAIT(); asm volatile("" ::: "memory");
    }
}
namespace fa {
typedef float f32x16 __attribute__((ext_vector_type(16)));
typedef short s16x4 __attribute__((ext_vector_type(4)));
constexpr float THR = 6.f;
__device__ __forceinline__ int crow(int r, int hi) { return (r & 3) + 8 * (r >> 2) + 4 * hi; }
struct Ptrs { const bf16_t* q; int ldq; const bf16_t* k1; int ldk1; const bf16_t* k2; int ldk2; const bf16_t* v; int ldv; const bf16_t* gate; int ldg; bf16_t* o; int ldo; };
template <int DQK, int DV> struct Geo {
    static constexpr int KROW = DQK * 2 + 16, KT = 64 * KROW, VT = 64 * DV * 2, BUF = KT + VT, NCB = DV / 32, ND0 = DQK / 16, WS_OFF = 2 * BUF, BYTES = WS_OFF + NWAVES * 256;
};
template <int NCB> __device__ __forceinline__ int v_st(int k, int c) { const int kk = (k & ~0xC) | ((k & 4) << 1) | ((k & 8) >> 1); return ((kk >> 3) * NCB + (c >> 5)) * 512 + ((kk & 7) * 32 + (c & 31)) * 2; }
__device__ __forceinline__ int v_rd_base(int lane) { return ((lane & 3) << 3) | (((lane >> 2) & 3) << 6) | (((lane >> 4) & 1) << 5) | (((lane >> 5) & 1) << 8); }

template <int DQK, int DK1, int DV, bool CAUSAL>
__device__ __forceinline__ void attn_block(LAS unsigned char* lds, const int wid, const Ptrs P, const int NT, const int q0) {
    typedef Geo<DQK, DV> G;
    constexpr int KROW = G::KROW, KT = G::KT, BUF = G::BUF, NCB = G::NCB, ND0 = G::ND0;
    constexpr int NKC1 = DK1 / 8, NKC2 = (DQK - DK1) / 8, NVC = DV / 8;
    constexpr int NK1 = 64 * NKC1 / 512, NK2 = 64 * NKC2 / 512, NV = 64 * NVC / 512;
    static_assert(NK1 >= 1 && NV >= 1 && (NKC2 == 0 || NK2 == 1), "staging geometry");
    const int lane = lane_id(), tid = wid * 64 + lane, r32 = lane & 31, hi = lane >> 5;
    constexpr int RP1 = 512 / NKC1, RPV = 512 / NVC;
    const int k1lds = (tid / NKC1) * KROW + (tid % NKC1) * 16, vlds = KT + v_st<NCB>(tid / NVC, (tid % NVC) * 8);
    const size_t k1g = (size_t)(tid / NKC1) * P.ldk1 + (tid % NKC1) * 8, vg = (size_t)(tid / NVC) * P.ldv + (tid % NVC) * 8;
    const int k2lds = NKC2 ? (tid / (NKC2 ? NKC2 : 1)) * KROW + (NKC1 + tid % (NKC2 ? NKC2 : 1)) * 16 : 0;
    const size_t k2g = NKC2 ? (size_t)(tid / (NKC2 ? NKC2 : 1)) * P.ldk2 + (tid % (NKC2 ? NKC2 : 1)) * 8 : 0;
    bf16x8 sk1[NK1], sk2, sv[NV];
#define FA_SLOADK(t) do { const size_t kb_ = (size_t)(t) * 64; \
        _Pragma("unroll") for (int i = 0; i < NK1; ++i) sk1[i] = *(const bf16x8*)(P.k1 + (kb_ + i * RP1) * P.ldk1 + k1g); \
        if (NKC2) sk2 = *(const bf16x8*)(P.k2 + kb_ * P.ldk2 + k2g); } while (0)
#define FA_SLOADV(t) do { const size_t kb_ = (size_t)(t) * 64; \
        _Pragma("unroll") for (int i = 0; i < NV; ++i) sv[i] = *(const bf16x8*)(P.v + (kb_ + i * RPV) * P.ldv + vg); } while (0)
#define FA_SLOAD(t) do { FA_SLOADK(t); FA_SLOADV(t); } while (0)
#define FA_SWRITE(bo) do { \
        _Pragma("unroll") for (int i = 0; i < NK1; ++i) *(LAS bf16x8*)(lds + (bo) + k1lds + i * RP1 * KROW) = sk1[i]; \
        if (NKC2) *(LAS bf16x8*)(lds + (bo) + k2lds) = sk2; \
        _Pragma("unroll") for (int i = 0; i < NV; ++i) *(LAS bf16x8*)(lds + (bo) + vlds + i * (RPV / 8) * NCB * 512) = sv[i]; } while (0)
    bf16x8 qr[ND0];
#pragma unroll
    for (int d0 = 0; d0 < ND0; ++d0) qr[d0] = *(const bf16x8*)(P.q + (size_t)(wid * 32 + r32) * P.ldq + d0 * 16 + hi * 8);
    LAS float* wsf = (LAS float*)(lds + G::WS_OFF) + wid * 64;
    float m_reg = -1e30f, l_reg = 0.f; f32x16 o[NCB];
#pragma unroll
    for (int d = 0; d < NCB; ++d) o[d] = f32x16{};
    const int lastt = CAUSAL ? ((q0 + wid * 32) >> 6) : NT - 1;
    const int vb0 = (int)(uintptr_t)(lds + KT) + v_rd_base(lane);
    FA_SLOAD(0); FA_SWRITE(0); __syncthreads();
    for (int t = 0; t < NT; ++t) {
        const int bo = (t & 1) * BUF;
        if (t + 1 < NT) FA_SLOADK(t + 1);
        if (t <= lastt) {
            f32x16 p0 = f32x16{}, p1 = f32x16{};
            const LAS unsigned char* kb = lds + bo + r32 * KROW + hi * 16;
#pragma unroll
            for (int d0 = 0; d0 < ND0; ++d0) { const bf16x8 b0 = *(const LAS bf16x8*)(kb + d0 * 32), b1 = *(const LAS bf16x8*)(kb + 32 * KROW + d0 * 32);
                p0 = __builtin_amdgcn_mfma_f32_32x32x16_bf16(b0, qr[d0], p0, 0, 0, 0); p1 = __builtin_amdgcn_mfma_f32_32x32x16_bf16(b1, qr[d0], p1, 0, 0, 0); }
            float pmax = p0[0];
#pragma unroll
            for (int r = 1; r < 16; ++r) pmax = fmaxf(pmax, p0[r]);
#pragma unroll
            for (int r = 0; r < 16; ++r) pmax = fmaxf(pmax, p1[r]);
            { auto rr = __builtin_amdgcn_permlane32_swap(__float_as_uint(pmax), __float_as_uint(pmax), false, false); pmax = fmaxf(__uint_as_float(rr[0]), __uint_as_float(rr[1])); }
            if (t + 1 < NT) FA_SLOADV(t + 1);
            float alpha = 1.f;
            if (!__all(pmax - m_reg <= THR)) { const float mn = fmaxf(m_reg, pmax); alpha = __builtin_amdgcn_exp2f(m_reg - mn); m_reg = mn;
                if (hi == 0) wsf[r32] = alpha; LDS_WAIT();
#pragma unroll
                for (int d = 0; d < NCB; ++d)
#pragma unroll
                    for (int r = 0; r < 16; ++r) o[d][r] *= wsf[crow(r, hi)];
            }
            float ps = 0.f;
#pragma unroll
            for (int r = 0; r < 16; ++r) { p0[r] = __builtin_amdgcn_exp2f(p0[r] - m_reg); p1[r] = __builtin_amdgcn_exp2f(p1[r] - m_reg); ps += p0[r] + p1[r]; }
            { auto rr = __builtin_amdgcn_permlane32_swap(__float_as_uint(ps), __float_as_uint(ps), false, false); ps = __uint_as_float(rr[0]) + __uint_as_float(rr[1]); }
            l_reg = l_reg * alpha + ps;
            bf16x8 pa0, pa1, pa2, pa3;
#define FA_PK4(Pv, B_, OUT) do { unsigned a0 = cvt_pk_bf16(Pv[B_ + 0], Pv[B_ + 1]), a1 = cvt_pk_bf16(Pv[B_ + 2], Pv[B_ + 3]), b0_ = cvt_pk_bf16(Pv[B_ + 4], Pv[B_ + 5]), b1_ = cvt_pk_bf16(Pv[B_ + 6], Pv[B_ + 7]); \
        auto r0 = __builtin_amdgcn_permlane32_swap(a0, b0_, false, false); auto r1 = __builtin_amdgcn_permlane32_swap(a1, b1_, false, false); \
        u32x4 w_ = {r0[0], r1[0], r0[1], r1[1]}; OUT = __builtin_bit_cast(bf16x8, w_); } while (0)
            FA_PK4(p0, 0, pa0); FA_PK4(p0, 8, pa1); FA_PK4(p1, 0, pa2); FA_PK4(p1, 8, pa3);
#undef FA_PK4
#define FA_TRRD(dst, off) asm volatile("ds_read_b64_tr_b16 %0, %1 offset:%2" : "=&v"(dst) : "v"(vbt), "i"(off) : "memory")
            const int vbt = vb0 + bo;
#pragma unroll
            for (int d0 = 0; d0 < NCB; ++d0) { s16x4 l0, l1, l2, l3, h0, h1, h2, h3;
                FA_TRRD(l0, (0 * NCB + d0) * 512); FA_TRRD(h0, (1 * NCB + d0) * 512); FA_TRRD(l1, (2 * NCB + d0) * 512); FA_TRRD(h1, (3 * NCB + d0) * 512);
                FA_TRRD(l2, (4 * NCB + d0) * 512); FA_TRRD(h2, (5 * NCB + d0) * 512); FA_TRRD(l3, (6 * NCB + d0) * 512); FA_TRRD(h3, (7 * NCB + d0) * 512);
                asm volatile("s_waitcnt lgkmcnt(0)" ::: "memory"); __builtin_amdgcn_sched_barrier(0);
                o[d0] = __builtin_amdgcn_mfma_f32_32x32x16_bf16(pa0, (bf16x8){l0[0], l0[1], l0[2], l0[3], h0[0], h0[1], h0[2], h0[3]}, o[d0], 0, 0, 0);
                o[d0] = __builtin_amdgcn_mfma_f32_32x32x16_bf16(pa1, (bf16x8){l1[0], l1[1], l1[2], l1[3], h1[0], h1[1], h1[2], h1[3]}, o[d0], 0, 0, 0);
                o[d0] = __builtin_amdgcn_mfma_f32_32x32x16_bf16(pa2, (bf16x8){l2[0], l2[1], l2[2], l2[3], h2[0], h2[1], h2[2], h2[3]}, o[d0], 0, 0, 0);
                o[d0] = __builtin_amdgcn_mfma_f32_32x32x16_bf16(pa3, (bf16x8){l3[0], l3[1], l3[2], l3[3], h3[0], h3[1], h3[2], h3[3]}, o[d0], 0, 0, 0); }
#undef FA_TRRD
        }
        if (t > lastt && t + 1 < NT) FA_SLOADV(t + 1);
        if (t + 1 < NT) FA_SWRITE(((t + 1) & 1) * BUF);
        __syncthreads();
    }
    if (hi == 0) wsf[32 + r32] = l_reg; LDS_WAIT();
    LAS bf16_t* stg = (LAS bf16_t*)(lds + wid * (32 * DV * 2));
#pragma unroll
    for (int r = 0; r < 16; ++r) { const float rl = __builtin_amdgcn_rcpf(wsf[32 + crow(r, hi)]); const int orow = crow(r, hi);
#pragma unroll
        for (int d0 = 0; d0 < NCB; ++d0) stg[orow * DV + d0 * 32 + r32] = (bf16_t)f2bf(o[d0][r] * rl); }
    LDS_WAIT(); asm volatile("" ::: "memory");
    constexpr int RPP = 64 / NVC;
#pragma unroll
    for (int i = 0; i < 32 / RPP; ++i) { const int row = i * RPP + lane / NVC, ch = lane % NVC;
        const u32x4 ov = *(const LAS u32x4*)(stg + row * DV + ch * 8);
        const u32x4 gv = *(const u32x4*)(P.gate + (size_t)(wid * 32 + row) * P.ldg + ch * 8);
        u32x4 w; w.x = pk2(bflo(ov.x) * bflo(gv.x), bfhi(ov.x) * bfhi(gv.x)); w.y = pk2(bflo(ov.y) * bflo(gv.y), bfhi(ov.y) * bfhi(gv.y));
        w.z = pk2(bflo(ov.z) * bflo(gv.z), bfhi(ov.z) * bfhi(gv.z)); w.w = pk2(bflo(ov.w) * bflo(gv.w), bfhi(ov.w) * bfhi(gv.w));
        *(u32x4*)(P.o + (size_t)(wid * 32 + row) * P.ldo + ch * 8) = w; }
    __syncthreads();
#undef FA_SLOAD
#undef FA_SLOADK
#undef FA_SLOADV
#undef FA_SWRITE
}
}
__device__ __forceinline__ void mla_phase(Frame& F, gu32* head) {
    volatile LAS unsigned* slot = F.MISC + 16;
    for (;;) {
        if (F.tid() == 0) slot[0] = __hip_atomic_fetch_add(head, 1u, RLX_AGENT);
        __syncthreads();
        const int I = (int)slot[0];
        __syncthreads();
        if (I >= 96 * 8) break;
        const int qb = 7 - I / 96, bh = I % 96, b = bh / 6, h = bh % 6;
        const size_t r0 = (size_t)b * SEQ, rq = r0 + qb * 256;
        fa::Ptrs P{F.Q() + rq * QLD + h * 192, QLD, F.KN() + r0 * KLD + h * 128, KLD, F.PROJ() + r0 * PLD + L1_KR, PLD, F.VV() + r0 * KLD + h * 128, KLD,
                   F.PROJ() + rq * PLD + L1_GATE + h * 128, PLD, F.BR() + rq * DM + h * 128, DM};
        fa::attn_block<192, 128, 128, true>(F.lds + RING_OFF, F.wave, P, 4 * qb + 4, qb * 256);
    }
}
__device__ __forceinline__ void memattn_phase(Frame& F, int layer, int mq_col, int gate_col) {
    for (int u = F.vcu; u < 16 * 8 * 4; u += F.G) {
        const int h = u & 3, tb = u >> 2; const size_t rq = (size_t)tb * 256, b = rq / SEQ;
        const bf16_t* kv = F.MEMKV() + (size_t)(b * NMEM) * 1024 + layer * 512 + h * 64;
        fa::Ptrs P{F.PROJ() + rq * PLD + mq_col + h * 64, PLD, kv, 1024, nullptr, 0, kv + 256, 1024,
                   F.PROJ() + rq * PLD + gate_col + 768 + h * 64, PLD, F.BR() + rq * DM + 768 + h * 64, DM};
        fa::attn_block<64, 64, 64, false>(F.lds + RING_OFF, F.wave, P, 4, 0);
    }
}
__device__ __forceinline__ void final_norm(Frame& F) {
    const int gw = F.vcu * NWAVES + F.wave, NGW = F.G * NWAVES;
    for (int m = gw; m < M; m += NGW) {
        const float r = 1.0f / sqrtf(F.ssq2()[m] * (1.f / 1024.f) + EPS);
        GAS f32x4* o = (GAS f32x4*)(F.out() + (size_t)m * DM) + F.lane(); const GAS f32x4* g = (const GAS f32x4*)F.final_norm_g() + F.lane();
#pragma unroll
        for (int j = 0; j < 4; ++j) { const f32x4 v = o[64 * j], gg = g[64 * j]; o[64 * j] = (f32x4){v.x * r * gg.x, v.y * r * gg.y, v.z * r * gg.z, v.w * r * gg.w}; }
    }
}

__device__ __forceinline__ void final_norm_dummy(Frame& F, float* dst) {
    const int gw = F.vcu * NWAVES + F.wave, NGW = F.G * NWAVES;
    for (int m = gw; m < M; m += NGW) {
        const float r = 1.0f / sqrtf(F.ssq2()[m] * (1.f / 1024.f) + EPS);
        const GAS f32x4* o = (const GAS f32x4*)(F.out() + (size_t)m * DM) + F.lane(); GAS f32x4* d = (GAS f32x4*)(dst + (size_t)m * DM) + F.lane(); const GAS f32x4* g = (const GAS f32x4*)F.final_norm_g() + F.lane();
#pragma unroll
        for (int j = 0; j < 4; ++j) { const f32x4 v = o[64 * j], gg = g[64 * j]; d[64 * j] = (f32x4){v.x * r * gg.x, v.y * r * gg.y, v.z * r * gg.z, v.w * r * gg.w}; }
    }
}
constexpr int N_PHASES = 9;
__global__ void __launch_bounds__(NWAVES * 64, 2) trunk_fwd(Args args) {
    extern __shared__ __attribute__((aligned(16))) unsigned char lds[];
    Frame F;
    F.lds = (LAS unsigned char*)lds;
    F.MISC = (volatile LAS unsigned*)(F.lds + MISC_OFF);
    F.wave = __builtin_amdgcn_readfirstlane((int)threadIdx.x >> 6);
    F.G = gridDim.x; { const int bx = blockIdx.x; F.vcu = (F.G % 8 == 0) ? (bx % 8) * (F.G / 8) + bx / 8 : bx; }
    unsigned char* ws = args.ws;
    F.ctl = (gu32*)(ws + WS_CTL);
    F.refresh();
    for (int u = F.tid(); u < (LDS_BYTES - LDSCTL_OFF) / 4; u += NWAVES * 64) ((LAS unsigned*)(F.lds + LDSCTL_OFF))[u] = 0u;
    __syncthreads();
    const int lo = args.ph_lo, hi = args.ph_hi;
    XcdBarrier bar; bar.bar = (unsigned*)(F.ctl + CW_BAR); bar.x = 0; bar.st = nullptr; bar.wave = F.wave;
    if (hi - lo > 1) bar = xcd_barrier_post((unsigned*)(F.ctl + CW_BAR), F.MISC + 8, F.wave);
#ifndef PHASE_MASK
#define PHASE_MASK 0x1ff
#endif
#define IN(k) (((PHASE_MASK >> (k)) & 1) && lo <= (k) && (k) < hi)
#define SEAM(k) do { if (IN(k) && IN((k) + 1)) xcd_barrier(bar); } while (0)
    const int bx = (int)blockIdx.x;
    const bool dmy = args.dummy != 0;
    float* const ssq_dummy = (float*)(ws + WS_END);
    if (IN(0)) { F.refresh(); p0_prologue(F); SEAM(0); }
    if (IN(1)) { F.refresh();

        pg8::Sched2 S{F.XN(), F.WIN0(), F.MN(), F.WMKV(), M, 2048, MROWS, 1024, 1024, 1024, F.G, bx};
        EpiP1 E{F.PROJ(), F.MEMKV()};
        pg8::gemm_phase(F.lds + RING_OFF, F.wave, 1024, 1024, 1024, S, E);
        SEAM(1);
    }
    if (IN(2)) { F.refresh(); pool_phase(F);
#if defined(MEMATTN_NAIVE)
        memattn_naive(F, 0, L0_MQ, L0_GATE);
#else
        memattn_phase(F, 0, L0_MQ, L0_GATE);
#endif

        SEAM(2); }
    if (IN(3)) { F.refresh();

        pg8::Sched1 S{F.BR(), F.WOUT0(), M, 1024, 1024, 1024, F.G, bx};
        EpiOut0 E{F.x(), F.XN(), dmy ? ssq_dummy : F.ssq1()};
        pg8::gemm_phase(F.lds + RING_OFF, F.wave, 1024, 1024, 1024, S, E);
        SEAM(3);
    }
    if (IN(4)) { F.refresh();

        pg8::Sched1 S{F.XN(), F.WIN1(), M, 2048, 1024, 1024, F.G, bx};
        EpiP4 E{F.PROJ(), F.ssq1(), dmy ? ssq_dummy : F.ssq_q(), dmy ? ssq_dummy + M : F.ssq_kv(), F.CS()};
        pg8::gemm_phase(F.lds + RING_OFF, F.wave, 1024, 1024, 1024, S, E);
        SEAM(4);
    }
    if (IN(5)) { F.refresh();

        { pg8::Sched1 S{F.PROJ(), F.WUQ(), M, 1280, PLD, 384, F.G, bx}; EpiQ E{F.Q(), F.ssq_q(), F.CS()};
          pg8::gemm_phase(F.lds + RING_OFF, F.wave, 384, PLD, 384, S, E); }
        { pg8::Sched1 S{F.PROJ() + L1_CKV, F.WUKV(), M, 1536, PLD, 256, F.G, bx}; EpiKV E{F.KN(), F.VV(), F.ssq_kv()};
          pg8::gemm_phase(F.lds + RING_OFF, F.wave, 256, PLD, 256, S, E); }

        SEAM(5);
    }
    if (IN(6)) { F.refresh();

#if defined(MLA_NAIVE)
        mla_naive(F);
#else
        mla_phase(F, F.ctl + CW_QHEAD + (dmy ? 64 : 0));
#endif
#if defined(MEMATTN_NAIVE)
        memattn_naive(F, 1, L1_MQ, L1_GATE);
#else
        memattn_phase(F, 1, L1_MQ, L1_GATE);
#endif

        SEAM(6); }
    if (IN(7)) { F.refresh();

        pg8::Sched1 S{F.BR(), F.WOUT1(), M, 1024, 1024, 1024, F.G, bx};
        EpiOut1 E{F.XN(), dmy ? (float*)(ws + WS_PROJ) : F.out(), dmy ? ssq_dummy : F.ssq2()};
        pg8::gemm_phase(F.lds + RING_OFF, F.wave, 1024, 1024, 1024, S, E);
        SEAM(7);
    }
    if (IN(8)) { F.refresh(); if (dmy) final_norm_dummy(F, (float*)(ws + WS_PROJ)); else final_norm(F); }
#undef IN
#undef SEAM
}

extern "C" void kernel_launch(void* const* d_in, const int* in_sizes, int n_in, void* d_out, int out_size, void* d_ws, size_t ws_size, hipStream_t stream) {
    static int grid = 0;
    if (grid == 0) {
        if (n_in != 16 || in_sizes[0] != M * DM || out_size != M * DM || ws_size < WS_END) { fprintf(stderr, "kernel_launch: unexpected shapes (n_in %d, in0 %d, out %d, ws %zu); nothing launched\n", n_in, n_in > 0 ? in_sizes[0] : -1, out_size, ws_size); grid = -1; return; }
        int dev = 0, cus = 0, per_cu = 0;
        if (hipGetDevice(&dev) != hipSuccess || hipDeviceGetAttribute(&cus, hipDeviceAttributeMultiprocessorCount, dev) != hipSuccess) { grid = -1; return; }
        if (hipFuncSetAttribute((const void*)trunk_fwd, hipFuncAttributeMaxDynamicSharedMemorySize, LDS_BYTES) != hipSuccess) { fprintf(stderr, "kernel_launch: hipFuncSetAttribute failed\n"); grid = -1; return; }
        if (hipOccupancyMaxActiveBlocksPerMultiprocessor(&per_cu, (const void*)trunk_fwd, NWAVES * 64, LDS_BYTES) != hipSuccess || per_cu < 1) { fprintf(stderr, "kernel_launch: occupancy query says %d blocks per CU; nothing launched\n", per_cu); (void)hipGetLastError(); grid = -1; return; }
        if (cus < 256) { fprintf(stderr, "kernel_launch: %d CUs, need 256; nothing launched\n", cus); grid = -1; return; }
        grid = 256;
    }
    if (grid < 0) return;
    (void)hipMemsetAsync((char*)d_ws + WS_CTL, 0, CTL_ZERO_BYTES, stream);
    Args a{};
    for (int i = 0; i < 16; ++i) a.in[i] = d_in[i];
    a.out = (float*)d_out; a.ws = (unsigned char*)d_ws;
    if (MK_N_LAUNCHES == 1) { a.ph_lo = 0; a.ph_hi = N_PHASES; hipLaunchKernelGGL(trunk_fwd, dim3(grid), dim3(NWAVES * 64), LDS_BYTES, stream, a); }
    else for (int p = 0; p < N_PHASES; ++p) {
#if defined(PROBE_PHASE)
        if (p == PROBE_PHASE) { a.ph_lo = p; a.ph_hi = p + 1; a.dummy = 1; hipLaunchKernelGGL(trunk_fwd, dim3(grid), dim3(NWAVES * 64), LDS_BYTES, stream, a); a.dummy = 0; }
#endif
        a.ph_lo = p; a.ph_hi = p + 1; hipLaunchKernelGGL(trunk_fwd, dim3(grid), dim3(NWAVES * 64), LDS_BYTES, stream, a); }
}
```
